# Optimizing an MI355X kernel written in HIP

```python
import jax, jax.numpy as jnp
from jax import lax
import numpy as np

D_MODEL = 1024
BATCH = 4
SEQ = 8192
DEPTH = 4

GRID_W = 64
NA_HEADS = 8
NA_HEAD_DIM = 64
NA_WIDTH = NA_HEADS * NA_HEAD_DIM
NA_ROWS = 8
NA_COLS = 16
RET_HEADS = 4
RET_QK_DIM = 64
RET_V_DIM = 2 * RET_QK_DIM
RET_QK_WIDTH = RET_HEADS * RET_QK_DIM
RET_V_WIDTH = RET_HEADS * RET_V_DIM
RET_CHUNK = 128
ROPE_BASE = 10000.0
MIX_WIDTH = NA_WIDTH + RET_V_WIDTH
IN_WIDTH = 3 * NA_WIDTH + 2 * RET_QK_WIDTH + 2 * RET_V_WIDTH
D_FF = 4 * D_MODEL
EPS = 1e-6
NEG = -1e30

kernel_name = 'hybrid_natten_retention_encoder'

F32 = jnp.float32


def rms_norm(x, gain):
    x32 = x.astype(F32)
    y = x32 * lax.rsqrt(jnp.mean(jnp.square(x32), axis=-1, keepdims=True) + EPS)
    return (y * gain.astype(F32)).astype(x.dtype)


def head_group_norm(y, gain):
    bsz, seq, heads, dv = y.shape
    mu = jnp.mean(y, axis=-1, keepdims=True)
    var = jnp.mean(jnp.square(y - mu), axis=-1, keepdims=True)
    y = (y - mu) * lax.rsqrt(var + EPS)
    return y.reshape(bsz, seq, heads * dv) * gain.astype(F32)


def rotary(x, pos):
    d = x.shape[-1]
    inv = 1.0 / (ROPE_BASE ** (jnp.arange(0, d, 2, dtype=F32) / d))
    ang = pos.astype(F32)[:, None] * inv[None, :]
    cos = jnp.cos(ang)[None, :, None, :]
    sin = jnp.sin(ang)[None, :, None, :]
    x1, x2 = x[..., : d // 2], x[..., d // 2:]
    return jnp.concatenate([x1 * cos - x2 * sin, x1 * sin + x2 * cos], axis=-1)


def neighbourhood_attention(q, k, v, rpb):
    bsz, seq, heads, dh = q.shape
    rows = seq // GRID_W
    kh = min(NA_ROWS, rows)
    n_cb = GRID_W // NA_COLS
    band = 2 * NA_COLS
    col = np.arange(GRID_W)
    col_start = np.clip(col - NA_COLS // 2, 0, GRID_W - NA_COLS)
    band_start = np.clip(np.arange(n_cb) * NA_COLS - NA_COLS // 2, 0, GRID_W - band)
    band_idx = band_start[:, None] + np.arange(band)
    q_col = col.reshape(n_cb, NA_COLS)
    lo = col_start[q_col][..., None]
    kcol = band_idx[:, None, :]
    valid = jnp.asarray((kcol >= lo) & (kcol < lo + NA_COLS))
    dc = np.clip(kcol - q_col[..., None], -(NA_COLS - 1), NA_COLS - 1) + NA_COLS - 1
    bias_c = rpb.astype(F32)[:, :, dc]

    kb = k.reshape(bsz, rows, GRID_W, heads, dh)[:, :, band_idx]
    vb = v.reshape(bsz, rows, GRID_W, heads, dh)[:, :, band_idx]
    q_rows = jnp.moveaxis(q.reshape(bsz, rows, n_cb, NA_COLS, heads, dh), 1, 0)
    scale = dh ** -0.5

    def one_row(args):
        q_row, r = args
        rs = jnp.clip(r - kh // 2, 0, rows - kh)
        k_win = lax.dynamic_slice_in_dim(kb, rs, kh, axis=1)
        v_win = lax.dynamic_slice_in_dim(vb, rs, kh, axis=1)
        s = jnp.einsum('bcqhd,bicjhd->bhcqij', q_row, k_win).astype(F32) * scale
        dr = rs - r + jnp.arange(kh) + NA_ROWS - 1
        bias = jnp.take(bias_c, dr, axis=1)
        s = s + jnp.transpose(bias, (0, 2, 3, 1, 4))[None]
        s = jnp.where(valid[None, None, :, :, None, :], s, NEG)
        p = jax.nn.softmax(s.reshape(s.shape[:4] + (kh * band,)), axis=-1)
        p = p.reshape(s.shape).astype(v.dtype)
        return jnp.einsum('bhcqij,bicjhd->bcqhd', p, v_win)

    out = lax.map(one_row, (q_rows, jnp.arange(rows)))
    return jnp.moveaxis(out, 0, 1).reshape(bsz, seq, heads * dh)


def retention_scan(q, k, v, log_gamma, include_diag):
    bsz, seq, heads, dk = q.shape
    dv = v.shape[-1]
    c = RET_CHUNK
    n = seq // c
    qc = q.reshape(bsz, n, c, heads, dk)
    kc = k.reshape(bsz, n, c, heads, dk)
    vc = v.reshape(bsz, n, c, heads, dv)
    idx = jnp.arange(c, dtype=F32)
    diff = idx[:, None] - idx[None, :]
    keep = (diff >= 0) if include_diag else (diff > 0)
    dmat = jnp.where(keep[None], jnp.exp(log_gamma[:, None, None] * jnp.maximum(diff, 0.0)[None]), 0.0)
    s = jnp.einsum('bnihd,bnjhd->bnhij', qc, kc) * dmat
    intra = jnp.einsum('bnhij,bnjhe->bnihe', s, vc)
    zeta = jnp.exp(log_gamma[:, None] * (c - 1 - idx)[None, :])
    chunk_kv = jnp.einsum('bnjhd,hj,bnjhe->nbhde', kc, zeta, vc)
    chunk_decay = jnp.exp(log_gamma * c)[None, :, None, None]

    def step(state, kv):
        return chunk_decay * state + kv, state

    _, prev = lax.scan(step, jnp.zeros((bsz, heads, dk, dv), F32), chunk_kv)
    xi = jnp.exp(log_gamma[:, None] * (idx + 1.0)[None, :])
    cross = jnp.einsum('bnihd,nbhde,hi->bnihe', qc, prev, xi)
    return (intra + cross).reshape(bsz, seq, heads, dv)


def bidirectional_retention(q, k, v, lg_fwd, lg_bwd):
    flip = lambda t: jnp.flip(t, axis=1)
    fwd = retention_scan(q, k, v, lg_fwd, True)
    bwd = flip(retention_scan(flip(q), flip(k), flip(v), lg_bwd, False))
    return fwd + bwd


def log_decay(z):
    return jnp.log1p(-jnp.exp(z.astype(F32)))


def setup_inputs(seed: int = 0) -> dict:
    key = jax.random.key(seed)
    ks = jax.random.split(key, 12)
    base_decay = -(5.0 + jnp.arange(RET_HEADS, dtype=F32)) * float(np.log(2.0))
    x = jax.random.normal(ks[0], (BATCH, SEQ, D_MODEL), F32)
    w_in = jax.random.normal(ks[1], (DEPTH, D_MODEL, IN_WIDTH), F32) * D_MODEL ** -0.5
    w_out = jax.random.normal(ks[2], (DEPTH, MIX_WIDTH, D_MODEL), F32) * MIX_WIDTH ** -0.5
    na_rpb = jax.random.normal(ks[3], (DEPTH, NA_HEADS, 2 * NA_ROWS - 1, 2 * NA_COLS - 1), F32) * 0.02
    ret_decay_fwd = base_decay[None] + 0.05 * jax.random.normal(ks[4], (DEPTH, RET_HEADS), F32)
    ret_decay_bwd = base_decay[None] + 0.05 * jax.random.normal(ks[5], (DEPTH, RET_HEADS), F32)
    ret_norm_gain = 1.0 + 0.02 * jax.random.normal(ks[6], (DEPTH, RET_V_WIDTH), F32)
    norm_mix = 1.0 + 0.02 * jax.random.normal(ks[7], (DEPTH, D_MODEL), F32)
    norm_mlp = 1.0 + 0.02 * jax.random.normal(ks[8], (DEPTH, D_MODEL), F32)
    w_up = jax.random.normal(ks[9], (DEPTH, D_MODEL, D_FF), F32) * D_MODEL ** -0.5
    w_down = jax.random.normal(ks[10], (DEPTH, D_FF, D_MODEL), F32) * D_FF ** -0.5
    norm_final = 1.0 + 0.02 * jax.random.normal(ks[11], (D_MODEL,), F32)
    return {'x': x, 'w_in': w_in, 'w_out': w_out, 'na_rpb': na_rpb,
            'ret_decay_fwd': ret_decay_fwd, 'ret_decay_bwd': ret_decay_bwd,
            'ret_norm_gain': ret_norm_gain, 'norm_mix': norm_mix, 'norm_mlp': norm_mlp,
            'w_up': w_up, 'w_down': w_down, 'norm_final': norm_final}


def reference(x, w_in, w_out, na_rpb, ret_decay_fwd, ret_decay_bwd, ret_norm_gain,
              norm_mix, norm_mlp, w_up, w_down, norm_final):
    bsz, seq, _ = x.shape
    pos = jnp.arange(seq)
    splits = np.cumsum([NA_WIDTH, NA_WIDTH, NA_WIDTH, RET_QK_WIDTH, RET_QK_WIDTH, RET_V_WIDTH])
    for l in range(DEPTH):
        h = rms_norm(x, norm_mix[l])
        proj = h @ w_in[l]
        na_q, na_k, na_v, r_q, r_k, r_v, r_g = jnp.split(proj, splits, axis=-1)
        na_out = neighbourhood_attention(na_q.reshape(bsz, seq, NA_HEADS, NA_HEAD_DIM),
                                         na_k.reshape(bsz, seq, NA_HEADS, NA_HEAD_DIM),
                                         na_v.reshape(bsz, seq, NA_HEADS, NA_HEAD_DIM),
                                         na_rpb[l])
        rq = rotary(r_q.reshape(bsz, seq, RET_HEADS, RET_QK_DIM).astype(F32), pos)
        rk = rotary(r_k.reshape(bsz, seq, RET_HEADS, RET_QK_DIM).astype(F32), pos) * RET_QK_DIM ** -0.5
        rv = r_v.reshape(bsz, seq, RET_HEADS, RET_V_DIM).astype(F32)
        ret = bidirectional_retention(rq, rk, rv, log_decay(ret_decay_fwd[l]), log_decay(ret_decay_bwd[l]))
        ret = head_group_norm(ret, ret_norm_gain[l])
        ret_out = (jax.nn.silu(r_g.astype(F32)) * ret).astype(x.dtype)
        mix = jnp.concatenate([na_out.astype(x.dtype), ret_out], axis=-1)
        x = x + mix @ w_out[l]
        h = rms_norm(x, norm_mlp[l])
        x = x + jnp.square(jax.nn.relu(h @ w_up[l])) @ w_down[l]
    return rms_norm(x, norm_final)
```

```cpp
#define NA_NOPF 1
#include <hip/hip_runtime.h>
#include <hip/hip_cooperative_groups.h>
#include <cstdio>
#include <cstdint>
#include <cmath>
namespace cg = cooperative_groups;

__device__ __forceinline__ int lane_opaque() { int l; asm volatile("v_mbcnt_lo_u32_b32 %0, -1, 0\n\tv_mbcnt_hi_u32_b32 %0, -1, %0" : "=v"(l)); return l; }
__device__ __forceinline__ float shx(float v, int mask, int lane) { return __int_as_float(__builtin_amdgcn_ds_bpermute((lane ^ mask) << 2, __float_as_int(v))); }
namespace pg8 {
#define PG8_LAS __attribute__((address_space(3)))
#define PG8_GAS __attribute__((address_space(1)))
typedef unsigned short bf16_t;
typedef short bf16x8 __attribute__((ext_vector_type(8)));
typedef float f32x4 __attribute__((ext_vector_type(4)));
typedef unsigned u32x4 __attribute__((ext_vector_type(4)));
constexpr int BM = 256, BK = 64, HALF = 128, HTB = HALF * BK * 2  , STAGE_BYTES = 8 * HTB, NXCD = 8, WGM = 4;

__host__ __device__ __forceinline__ int lds_byte(int r, int c) { const int st = (r >> 4) * 2 + (c >> 5), rr = r & 15, cc = c & 31, ob = rr * 64 + cc * 2; return st * 1024 + (ob ^ (((ob >> 9) & 1) << 5)); }
__host__ __device__ __forceinline__ void stage_rc(int b, int& R, int& C) { const int st = b / 1024, sb = b % 1024, swz = sb ^ (((sb >> 9) & 1) << 5); R = (st >> 1) * 16 + swz / 64; C = (st & 1) * 32 + (swz % 64) / 2; }
__host__ __device__ __forceinline__ int perm32(int rho) { const int n = rho >> 4, i = rho & 15; return 8 * (i >> 2) + 4 * n + (i & 3); }

struct Unit { int pm, pn; };
struct Gemm { const PG8_GAS bf16_t* A; const PG8_GAS bf16_t* Bt; int M, N, K, lda; };

struct StaticOrder {
    int nM, nN, nwg, G, c;
    __host__ __device__ void init(int M, int N, int G_, int c_) { nM = M / BM; nN = N / BM; nwg = nM * nN; G = G_; c = c_; }
    __host__ __device__ bool next(int i, Unit& u) const {
        const long L = (long)i * G + c; if (L >= nwg) return false;
        int wgid = (int)L; { const int q = nwg / NXCD, r = nwg % NXCD, xcd = wgid % NXCD, off = wgid / NXCD; wgid = (xcd < r ? xcd * (q + 1) : r * (q + 1) + (xcd - r) * q) + off; }
        const int nig = WGM * nN, gid = wgid / nig, fm = gid * WGM, gsz = (nM - fm) < WGM ? (nM - fm) : WGM;
        u.pm = fm + ((wgid % nig) % gsz); u.pn = (wgid % nig) / gsz; return true;
    }
    __device__ __forceinline__ void a_ready(const Unit&) const {}
    __device__ __forceinline__ void done(const Unit&) const {}
};


__device__ __forceinline__ unsigned cvt_pk_bf16(float lo, float hi) { unsigned r; asm("v_cvt_pk_bf16_f32 %0, %1, %2" : "=v"(r) : "v"(lo), "v"(hi)); return r; }
constexpr float RMS_EPS = 1e-6f;
constexpr float SS_SCALE = 1048576.0f, SS_INV = 1.0f / (1048576.0f * 1024.0f);
typedef unsigned long long u64_t;
__device__ __forceinline__ float rs_from(u64_t v) { return __builtin_amdgcn_rsqf((float)v * SS_INV + RMS_EPS); }

struct EpiInMain {
    static constexpr bool PERM = true, AFTER_DRAIN = false;
    PG8_GAS unsigned char* wsb; int rsoff;
    __device__ __forceinline__ void operator()(const f32x4 (&acc)[2][2][4][2], const Unit& u, int wr, int wc, int fr, int fq) const {
        const int row0 = u.pm * BM + wr * 64 + fr, col0 = u.pn * BM + wc * 32 + 8 * fq;
        const bool rot = u.pn >= 6; const int d0 = 16 * (wc & 1) + 4 * fq;
        PG8_GAS bf16_t* O = (PG8_GAS bf16_t*)(wsb + ((size_t)164 << 20)); const PG8_GAS u64_t* rowss = (const PG8_GAS u64_t*)(wsb + rsoff); const PG8_GAS float* cost = (const PG8_GAS float*)(wsb + (1u << 20)); const PG8_GAS float* sint = (const PG8_GAS float*)(wsb + (2u << 20));
#pragma unroll
        for (int ai = 0; ai < 2; ++ai)
#pragma unroll
            for (int m = 0; m < 4; ++m) {
                const int row = row0 + ai * HALF + m * 16;
                const float rs = rs_from(rowss[row]);
                f32x4 cs = (f32x4){1.f, 1.f, 1.f, 1.f}, sn = (f32x4){0.f, 0.f, 0.f, 0.f};
                if (rot) { const int pos = row & 8191; cs = *(const PG8_GAS f32x4*)(cost + pos * 32 + d0); sn = *(const PG8_GAS f32x4*)(sint + pos * 32 + d0); }
                PG8_GAS bf16_t* rowp = O + (size_t)row * 2048 + col0;
#pragma unroll
                for (int bj = 0; bj < 2; ++bj) {
                    const f32x4 a = acc[ai][bj][m][0] * rs, b = acc[ai][bj][m][1] * rs;
                    const f32x4 v0 = a * cs - b * sn, v1 = a * sn + b * cs;
                    u32x4 w; w.x = cvt_pk_bf16(v0[0], v0[1]); w.y = cvt_pk_bf16(v0[2], v0[3]); w.z = cvt_pk_bf16(v1[0], v1[1]); w.w = cvt_pk_bf16(v1[2], v1[3]);
                    *(PG8_GAS u32x4*)(rowp + bj * HALF) = w; }
            }
    }
};
struct EpiInT {
    static constexpr bool PERM = true, AFTER_DRAIN = false;
    PG8_GAS unsigned char* wsb; int rsoff;
    __device__ __forceinline__ void operator()(const f32x4 (&acc)[2][2][4][2], const Unit& u, int wr, int wc, int fr, int fq) const {
        const int row0 = u.pm * BM + wr * 64 + fr, col0 = u.pn * BM + wc * 32 + 8 * fq;
        PG8_GAS bf16_t* O = (PG8_GAS bf16_t*)(wsb + ((size_t)292 << 20)); const PG8_GAS u64_t* rowss = (const PG8_GAS u64_t*)(wsb + rsoff);
        f32x4 rs[2][2];
#pragma unroll
        for (int bj = 0; bj < 2; ++bj)
#pragma unroll
            for (int n = 0; n < 2; ++n) {
#pragma unroll
                for (int e = 0; e < 4; ++e) rs[bj][n][e] = rs_from(rowss[col0 + bj * HALF + 4 * n + e]); }
#pragma unroll
        for (int ai = 0; ai < 2; ++ai)
#pragma unroll
            for (int m = 0; m < 4; ++m) {
                PG8_GAS bf16_t* rowp = O + (size_t)(row0 + ai * HALF + m * 16) * 32768 + col0;
#pragma unroll
                for (int bj = 0; bj < 2; ++bj) {
                    const f32x4 v0 = acc[ai][bj][m][0] * rs[bj][0], v1 = acc[ai][bj][m][1] * rs[bj][1];
                    u32x4 w; w.x = cvt_pk_bf16(v0[0], v0[1]); w.y = cvt_pk_bf16(v0[2], v0[3]); w.z = cvt_pk_bf16(v1[0], v1[1]); w.w = cvt_pk_bf16(v1[2], v1[3]);
                    *(PG8_GAS u32x4*)(rowp + bj * HALF) = w; }
            }
    }
};
struct EpiUp {
    static constexpr bool PERM = true, AFTER_DRAIN = false;
    PG8_GAS unsigned char* wsb; int rsoff;
    __device__ __forceinline__ void operator()(const f32x4 (&acc)[2][2][4][2], const Unit& u, int wr, int wc, int fr, int fq) const {
        const int row0 = u.pm * BM + wr * 64 + fr, col0 = u.pn * BM + wc * 32 + 8 * fq;
        PG8_GAS bf16_t* O = (PG8_GAS bf16_t*)(wsb + ((size_t)164 << 20)); const PG8_GAS u64_t* rowss = (const PG8_GAS u64_t*)(wsb + rsoff);
#pragma unroll
        for (int ai = 0; ai < 2; ++ai)
#pragma unroll
            for (int m = 0; m < 4; ++m) {
                const int row = row0 + ai * HALF + m * 16;
                const float rs = rs_from(rowss[row]);
                PG8_GAS bf16_t* rowp = O + (size_t)row * 4096 + col0;
#pragma unroll
                for (int bj = 0; bj < 2; ++bj) {
                    f32x4 v0 = acc[ai][bj][m][0] * rs, v1 = acc[ai][bj][m][1] * rs;
#pragma unroll
                    for (int e = 0; e < 4; ++e) { const float a = fmaxf(v0[e], 0.f), b = fmaxf(v1[e], 0.f); v0[e] = a * a; v1[e] = b * b; }
                    u32x4 w; w.x = cvt_pk_bf16(v0[0], v0[1]); w.y = cvt_pk_bf16(v0[2], v0[3]); w.z = cvt_pk_bf16(v1[0], v1[1]); w.w = cvt_pk_bf16(v1[2], v1[3]);
                    *(PG8_GAS u32x4*)(rowp + bj * HALF) = w; }
            }
    }
};
struct EpiRes {
    static constexpr bool PERM = true, AFTER_DRAIN = false;
    PG8_GAS unsigned char* wsb; int rsoff;
    __device__ __forceinline__ void operator()(const f32x4 (&acc)[2][2][4][2], const Unit& u, int wr, int wc, int fr, int fq) const {
        const int row0 = u.pm * BM + wr * 64 + fr, col0 = u.pn * BM + wc * 32 + 8 * fq;
        PG8_GAS bf16_t* xb = (PG8_GAS bf16_t*)(wsb + ((size_t)100 << 20)); PG8_GAS u64_t* rowss = (PG8_GAS u64_t*)(wsb + rsoff);
        const int ln = fq * 16 + fr;
#pragma unroll
        for (int ai = 0; ai < 2; ++ai) {
            u32x4 pre[2][4][2];
#pragma unroll
            for (int m = 0; m < 4; ++m)
#pragma unroll
                for (int bj = 0; bj < 2; ++bj) pre[ai][m][bj] = *(const PG8_GAS u32x4*)(xb + (size_t)(row0 + ai * HALF + m * 16) * 1024 + col0 + bj * HALF);
#pragma unroll
            for (int m = 0; m < 4; ++m) {
                const int row = row0 + ai * HALF + m * 16; const size_t off = (size_t)row * 1024 + col0;
                float ss = 0.f;
#pragma unroll
                for (int bj = 0; bj < 2; ++bj) {
                    const u32x4 p = pre[ai][m][bj];
                    f32x4 v0 = acc[ai][bj][m][0], v1 = acc[ai][bj][m][1];
                    v0[0] += __uint_as_float(p.x << 16); v0[1] += __uint_as_float(p.x & 0xffff0000u); v0[2] += __uint_as_float(p.y << 16); v0[3] += __uint_as_float(p.y & 0xffff0000u);
                    v1[0] += __uint_as_float(p.z << 16); v1[1] += __uint_as_float(p.z & 0xffff0000u); v1[2] += __uint_as_float(p.w << 16); v1[3] += __uint_as_float(p.w & 0xffff0000u);
                    u32x4 w; w.x = cvt_pk_bf16(v0[0], v0[1]); w.y = cvt_pk_bf16(v0[2], v0[3]); w.z = cvt_pk_bf16(v1[0], v1[1]); w.w = cvt_pk_bf16(v1[2], v1[3]);
                    *(PG8_GAS u32x4*)(xb + off + bj * HALF) = w;
                    ss += (v0[0] * v0[0] + v0[1] * v0[1]) + (v0[2] * v0[2] + v0[3] * v0[3]) + (v1[0] * v1[0] + v1[1] * v1[1]) + (v1[2] * v1[2] + v1[3] * v1[3]); }
                ss += shx(ss, 16, ln); ss += shx(ss, 32, ln);
                if (fq == 0) __hip_atomic_fetch_add(rowss + row, (u64_t)(ss * SS_SCALE + 0.5f), __ATOMIC_RELAXED, __HIP_MEMORY_SCOPE_AGENT);
            }
        }
    }
};

template <class Epi, class Sched, bool ALIGN_EPI = false, bool SP2 = false>
__device__ __forceinline__ void gemm_phase(PG8_LAS unsigned char* lds, const Gemm g, const Sched& S, const Epi& E, int tid_in) {
    int tid_ = tid_in; asm volatile("" : "+v"(tid_));
    const int tid = tid_, wid = __builtin_amdgcn_readfirstlane(tid >> 6), lane = tid & 63, wr = wid >> 2, wc = wid & 3, fr = lane & 15, fq = lane >> 4;
    const int K = g.K, nt = K / BK;
    unsigned voffA[2], voffB[2];
#pragma unroll
    for (int i = 0; i < 2; ++i) { int R, C; stage_rc(tid * 16 + i * 8192, R, C); const int Rb = Epi::PERM ? ((R & ~31) + perm32(R & 31)) : R;
        voffA[i] = (unsigned)(R * g.lda + C) * 2u; voffB[i] = (unsigned)(Rb * K + C) * 2u; }
    const size_t kstep = (size_t)(BK * 2);
    const size_t hstep = (size_t)HALF * K * 2;
    const size_t tstep = 2 * hstep; const size_t hstepA = (size_t)HALF * g.lda * 2, tstepA = 2 * hstepA;
    const unsigned ldsw = (unsigned)wid * 1024u;
    const int aoff = lds_byte(wr * 64 + fr, fq * 8), boff = lds_byte(wc * 32 + fr, fq * 8);
#define PG8_SA(b, h) (((b) * 2 + (h)) * HTB)
#define PG8_SB(b, h) ((4 + (b) * 2 + (h)) * HTB)
#define PG8_STAGE(bufoff, gbase, voff) do { _Pragma("unroll") for (int _i = 0; _i < 2; ++_i) \
        __builtin_amdgcn_global_load_lds((const PG8_GAS unsigned*)((const PG8_GAS char*)(gbase) + (voff)[_i]), (PG8_LAS unsigned*)(lds + (bufoff) + ldsw + _i * 8192), 16, 0, 0); } while (0)
#define PG8_LDA(dst, b, h) do { _Pragma("unroll") for (int m = 0; m < 4; ++m) _Pragma("unroll") for (int k = 0; k < 2; ++k) dst[m][k] = *(const PG8_LAS bf16x8*)(lds + PG8_SA(b, h) + aoff + m * 2048 + k * 1024); } while (0)
#define PG8_LDB(dst, b, h) do { _Pragma("unroll") for (int n = 0; n < 2; ++n) _Pragma("unroll") for (int k = 0; k < 2; ++k) dst[n][k] = *(const PG8_LAS bf16x8*)(lds + PG8_SB(b, h) + boff + n * 2048 + k * 1024); } while (0)
#define PG8_MMA(ai, bj, At, Bt) do { __builtin_amdgcn_s_setprio(1); _Pragma("unroll") for (int m = 0; m < 4; ++m) _Pragma("unroll") for (int n = 0; n < 2; ++n) _Pragma("unroll") for (int k = 0; k < 2; ++k) \
        acc[ai][bj][m][n] = __builtin_amdgcn_mfma_f32_16x16x32_bf16(Bt[n][k], At[m][k], acc[ai][bj][m][n], 0, 0, 0); __builtin_amdgcn_s_setprio(0); } while (0)
#define PG8_WAIT_V(n) asm volatile("s_waitcnt vmcnt(" #n ")" ::: "memory")
#define PG8_WAIT_L(n) asm volatile("s_waitcnt lgkmcnt(" #n ")" ::: "memory")
#define PG8_BAR __builtin_amdgcn_s_barrier()
#define PG8_SCHED __builtin_amdgcn_sched_barrier(0)
    Unit cur, nxt; int ui = 0;
    if (!S.next(0, cur)) return;
    f32x4 acc[2][2][4][2];
#pragma unroll
    for (int a = 0; a < 2; ++a)
#pragma unroll
        for (int b = 0; b < 2; ++b)
#pragma unroll
            for (int m = 0; m < 4; ++m)
#pragma unroll
                for (int n = 0; n < 2; ++n) acc[a][b][m][n] = (f32x4){0.f, 0.f, 0.f, 0.f};
    bf16x8 At[4][2], B0[2][2], B1[2][2];
    const PG8_GAS char* cA = (const PG8_GAS char*)g.A + (size_t)cur.pm * tstepA; const PG8_GAS char* cB = (const PG8_GAS char*)g.Bt + (size_t)cur.pn * tstep;
    S.a_ready(cur);
    if constexpr (SP2) {
        PG8_STAGE(PG8_SB(0, 0), cB, voffB); PG8_STAGE(PG8_SB(0, 1), cB + hstep, voffB); PG8_STAGE(PG8_SA(0, 0), cA, voffA); PG8_STAGE(PG8_SA(0, 1), cA + hstepA, voffA);
        if (wr == 1) PG8_BAR;
        PG8_WAIT_V(2); PG8_BAR;
        PG8_STAGE(PG8_SB(1, 0), cB + kstep, voffB); PG8_STAGE(PG8_SA(1, 0), cA + kstep, voffA); PG8_STAGE(PG8_SB(1, 1), cB + hstep + kstep, voffB);
        PG8_WAIT_V(6); PG8_BAR;
    } else {
        PG8_STAGE(PG8_SB(0, 0), cB, voffB); PG8_STAGE(PG8_SA(0, 0), cA, voffA); PG8_STAGE(PG8_SB(0, 1), cB + hstep, voffB); PG8_STAGE(PG8_SA(0, 1), cA + hstepA, voffA);
        if (wr == 1) PG8_BAR;
        PG8_WAIT_V(4); PG8_BAR;
        PG8_STAGE(PG8_SB(1, 0), cB + kstep, voffB); PG8_STAGE(PG8_SA(1, 0), cA + kstep, voffA); PG8_STAGE(PG8_SB(1, 1), cB + hstep + kstep, voffB);
        PG8_WAIT_V(6); PG8_BAR;
    }
    for (;;) {
        const bool has_next = S.next(ui + 1, nxt);
        const PG8_GAS char* nA = has_next ? (const PG8_GAS char*)g.A + (size_t)nxt.pm * tstepA : cA; const PG8_GAS char* nB = has_next ? (const PG8_GAS char*)g.Bt + (size_t)nxt.pn * tstep : cB;
        for (int t = 0; t < nt; t += 2) {
            const bool last = (t == nt - 2);
            const PG8_GAS char* a1 = cA + (size_t)(t + 1) * kstep;
            const PG8_GAS char* a2 = last ? nA : cA + (size_t)(t + 2) * kstep; const PG8_GAS char* b2 = last ? nB : cB + (size_t)(t + 2) * kstep;
            const PG8_GAS char* a3 = a2 + kstep; const PG8_GAS char* b3 = b2 + kstep;
            if (last && has_next) S.a_ready(nxt);
            if constexpr (SP2) {
            PG8_LDB(B0, 0, 0); PG8_LDB(B1, 0, 1); PG8_SCHED; PG8_LDA(At, 0, 0); PG8_STAGE(PG8_SA(1, 1), a1 + hstepA, voffA);
            PG8_WAIT_V(8); PG8_WAIT_L(0); PG8_BAR; PG8_MMA(0, 0, At, B0); PG8_MMA(0, 1, At, B1); PG8_BAR; PG8_SCHED;
            PG8_LDA(At, 0, 1); PG8_STAGE(PG8_SB(0, 0), b2, voffB); PG8_STAGE(PG8_SB(0, 1), b2 + hstep, voffB); PG8_STAGE(PG8_SA(0, 0), a2, voffA);
            PG8_WAIT_V(8); PG8_WAIT_L(0); PG8_BAR; PG8_MMA(1, 0, At, B0); PG8_MMA(1, 1, At, B1); PG8_BAR; PG8_SCHED;
            PG8_LDB(B0, 1, 0); PG8_LDB(B1, 1, 1); PG8_SCHED; PG8_LDA(At, 1, 0); PG8_STAGE(PG8_SA(0, 1), a2 + hstepA, voffA);
            PG8_WAIT_V(8); PG8_WAIT_L(0); PG8_BAR; PG8_MMA(0, 0, At, B0); PG8_MMA(0, 1, At, B1); PG8_BAR; PG8_SCHED;
            PG8_LDA(At, 1, 1); PG8_STAGE(PG8_SB(1, 0), b3, voffB); PG8_STAGE(PG8_SB(1, 1), b3 + hstep, voffB); PG8_STAGE(PG8_SA(1, 0), a3, voffA);
            PG8_WAIT_V(8); PG8_WAIT_L(0); PG8_BAR; PG8_MMA(1, 0, At, B0); PG8_MMA(1, 1, At, B1); PG8_BAR; PG8_SCHED;
            } else {
            PG8_LDB(B0, 0, 0); PG8_SCHED; PG8_LDA(At, 0, 0); PG8_STAGE(PG8_SA(1, 1), a1 + hstepA, voffA);
            PG8_WAIT_L(8); PG8_BAR; PG8_WAIT_L(0); PG8_MMA(0, 0, At, B0); PG8_BAR; PG8_SCHED;
            PG8_LDB(B1, 0, 1); PG8_STAGE(PG8_SB(0, 0), b2, voffB);
            PG8_BAR; PG8_WAIT_L(0); PG8_MMA(0, 1, At, B1); PG8_BAR;
            PG8_LDA(At, 0, 1); PG8_STAGE(PG8_SA(0, 0), a2, voffA);
            PG8_BAR; PG8_WAIT_L(0); PG8_MMA(1, 0, At, B0); PG8_BAR; PG8_SCHED;
            PG8_STAGE(PG8_SB(0, 1), b2 + hstep, voffB);
            PG8_WAIT_V(6); PG8_BAR; PG8_MMA(1, 1, At, B1); PG8_BAR;
            PG8_LDB(B0, 1, 0); PG8_SCHED; PG8_LDA(At, 1, 0); PG8_STAGE(PG8_SA(0, 1), a2 + hstepA, voffA);
            PG8_WAIT_L(8); PG8_BAR; PG8_WAIT_L(0); PG8_MMA(0, 0, At, B0); PG8_BAR; PG8_SCHED;
            PG8_LDB(B1, 1, 1); PG8_STAGE(PG8_SB(1, 0), b3, voffB);
            PG8_BAR; PG8_WAIT_L(0); PG8_MMA(0, 1, At, B1); PG8_BAR;
            PG8_LDA(At, 1, 1); PG8_STAGE(PG8_SA(1, 0), a3, voffA);
            PG8_BAR; PG8_WAIT_L(0); PG8_MMA(1, 0, At, B0); PG8_BAR; PG8_SCHED;
            PG8_STAGE(PG8_SB(1, 1), b3 + hstep, voffB);
            PG8_WAIT_V(6); PG8_BAR; PG8_MMA(1, 1, At, B1); PG8_BAR;
            }
        }
        if constexpr (ALIGN_EPI) { if (wr == 0) PG8_BAR; }
        if constexpr (!Epi::AFTER_DRAIN) { E(acc, cur, wr, wc, fr, fq); S.done(cur); }
        if (!has_next) break;
#pragma unroll
        for (int a = 0; a < 2; ++a)
#pragma unroll
            for (int b = 0; b < 2; ++b)
#pragma unroll
                for (int m = 0; m < 4; ++m)
#pragma unroll
                    for (int n = 0; n < 2; ++n) acc[a][b][m][n] = (f32x4){0.f, 0.f, 0.f, 0.f};
        cur = nxt; cA = nA; cB = nB; ++ui;
        if constexpr (ALIGN_EPI) { if (wr == 1) PG8_BAR; }
    }
    PG8_WAIT_V(0);
    if constexpr (!ALIGN_EPI) { if (wr == 0) PG8_BAR; }
    PG8_BAR;
    if constexpr (Epi::AFTER_DRAIN) { E.fused(acc, cur, wr, wc, fr, fq, lds, wid, lane); S.done(cur); }
#undef PG8_SA
#undef PG8_SB
#undef PG8_STAGE
#undef PG8_LDA
#undef PG8_LDB
#undef PG8_MMA
#undef PG8_WAIT_V
#undef PG8_WAIT_L
#undef PG8_BAR
#undef PG8_SCHED
}
}

#define LAS __attribute__((address_space(3)))
#define GAS __attribute__((address_space(1)))
typedef pg8::bf16_t bf16_t;
typedef pg8::bf16x8 bf16x8;
typedef pg8::f32x4 f32x4;
typedef pg8::u32x4 u32x4;
typedef unsigned u32x2 __attribute__((ext_vector_type(2)));
using pg8::cvt_pk_bf16;

constexpr int NWAVES = 8, NTHREADS = 512;
constexpr int BATCH = 4, SEQ = 8192, DM = 1024, DEPTH = 4, MTOK = BATCH * SEQ, FF = 4096;
constexpr int PW = 2048;
constexpr int PC_NAQ = 0, PC_GATE = 512, PC_NAK = 1024, PC_RQ = 1536, PC_RK = 1792;
constexpr int VT_NAV = 0, VT_RV = 512;
constexpr float LOG2E = 1.4426950408889634f;
constexpr float GN_EPS = 1e-6f;
constexpr size_t OFF_IN = 0, OFF_OUT = (size_t)3072 * 1024, OFF_UP = OFF_OUT + (size_t)1024 * 1024, OFF_DN = OFF_UP + (size_t)4096 * 1024, LAYER_W = OFF_DN + (size_t)1024 * 4096;
constexpr size_t MiB = 1u << 20;
constexpr size_t WS_BAR = 512 * 1024, BAR_ZERO_BYTES = 16 * 1024;
constexpr size_t WS_ROWSSA = 0, WS_ROWSSB = 256 * 1024, WS_COS = 1 * MiB, WS_SIN = 2 * MiB, WS_W = 4 * MiB;
constexpr size_t WS_XB = 100 * MiB;
constexpr size_t WS_P = 164 * MiB;
constexpr size_t WS_VT = 292 * MiB;
constexpr size_t WS_S = 356 * MiB;
constexpr size_t WS_U = 164 * MiB;
constexpr size_t WS_KV = 420 * MiB;
constexpr size_t WS_END = 484 * MiB;
static_assert(WS_W + DEPTH * LAYER_W * 2 <= WS_XB, "weights fit");
static_assert(WS_P == ((size_t)164 << 20) && WS_VT == ((size_t)292 << 20) && WS_U == ((size_t)164 << 20) && WS_XB == ((size_t)100 << 20) && WS_COS == (1u << 20) && WS_SIN == (2u << 20), "epilogue offsets");
constexpr int LDS_BYTES = 147456, LDSCTL_OFF = 146464, MISC_OFF = LDSCTL_OFF;

__device__ __forceinline__ f32x4 mfma16(bf16x8 a, bf16x8 b, f32x4 c) { return __builtin_amdgcn_mfma_f32_16x16x32_bf16(a, b, c, 0, 0, 0); }
__device__ __forceinline__ float wave_sum(float v, int lane) {
#pragma unroll
    for (int o = 1; o < 64; o <<= 1) v += shx(v, o, lane);
    return v;
}
__device__ __forceinline__ float bf2f(unsigned short b) { return __uint_as_float((unsigned)b << 16); }
__device__ __forceinline__ float ex2(float x) { return __builtin_amdgcn_exp2f(x); }
__device__ __forceinline__ float log2_decay(float z) { return log1pf(-expf(z)) * LOG2E; }

__device__ __forceinline__ int permq(int c) { const int h = c >> 6, p = c & 63, j = p >> 3, s = p & 7; return h * 64 + ((s < 4) ? (4 * j + s) : (32 + 4 * j + (s - 4))); }
__device__ __forceinline__ int srccol_in(int nd, float& sc) {
    sc = 1.f;
    if (nd < 512) { sc = 0.125f; return nd; }
    if (nd < 1024) return 2560 + (nd - 512);
    if (nd < 1536) return 512 + (nd - 1024);
    if (nd < 1792) return 1536 + permq(nd - 1536);
    if (nd < 2048) { sc = 0.125f; return 1792 + permq(nd - 1792); }
    if (nd < 2560) return 1024 + (nd - 2048);
    return 2048 + (nd - 2560);
}
template <int MODE>
__device__ __forceinline__ void transpose_item(const GAS float* W, int K, int N, GAS bf16_t* WT, const GAS float* gain, LAS float* scr, int item, int lane) {
    const int nblk = N / 32, kb = item / nblk, nb = item % nblk, k0 = 64 * kb, n0 = 32 * nb;
    float csc = 1.f; int sc = n0 + (lane & 31);
    if (MODE == 1) sc = srccol_in(n0 + (lane & 31), csc);
    float wv[32];
#pragma unroll
    for (int i = 0; i < 32; ++i) wv[i] = W[(size_t)(k0 + 2 * i + (lane >> 5)) * N + sc];
    float gv[32];
#pragma unroll
    for (int i = 0; i < 32; ++i) gv[i] = gain ? gain[k0 + 2 * i + (lane >> 5)] * csc : csc;
#pragma unroll
    for (int i = 0; i < 32; ++i) scr[(2 * i + (lane >> 5)) * 33 + (lane & 31)] = wv[i] * gv[i];
    asm volatile("s_waitcnt lgkmcnt(0)" ::: "memory");
    const int c = lane & 7;
#pragma unroll
    for (int j = 0; j < 4; ++j) { const int n = (lane >> 3) + 8 * j; const LAS float* s = scr + (8 * c) * 33 + n;
        u32x4 o; o.x = cvt_pk_bf16(s[0 * 33], s[1 * 33]); o.y = cvt_pk_bf16(s[2 * 33], s[3 * 33]); o.z = cvt_pk_bf16(s[4 * 33], s[5 * 33]); o.w = cvt_pk_bf16(s[6 * 33], s[7 * 33]);
        *(GAS u32x4*)(WT + (size_t)(n0 + n) * K + k0 + 8 * c) = o; }
    asm volatile("s_waitcnt lgkmcnt(0)" ::: "memory");
}

struct Params {
    const float* x; const float* w_in; const float* w_out; const float* rpb; const float* dfw; const float* dbw; const float* rgain;
    const float* nmix; const float* nmlp; const float* w_up; const float* w_down; const float* nfinal;
    float* out; unsigned char* ws; double inv2pi0; double rbase;
};

#define SCHED_FENCE() __builtin_amdgcn_sched_barrier(0)
template <bool DRY = false>
__device__ __forceinline__ void na_task(GAS bf16_t* P, const GAS bf16_t* VT, const LAS float* rpb, int b, int r, int cb, int h, int lane) {
    const int g = lane >> 4, qi = lane & 15;
    const int rs0 = min(max(r - 4, 0), 120), bs = min(max(cb * 16 - 8, 0), 32);
    const int c = cb * 16 + qi, cs = min(max(c - 8, 0), 48);
    const size_t tokq = (size_t)b * SEQ + r * 64 + c;
    GAS bf16_t* qp = P + tokq * PW + PC_NAQ + h * 64;
    const bf16x8 q0 = *(const GAS bf16x8*)(qp + 16 * g), q1 = *(const GAS bf16x8*)(qp + 16 * g + 8);
    const GAS bf16_t* kbase = P + ((size_t)b * SEQ + rs0 * 64 + bs + qi) * PW + PC_NAK + h * 64 + 16 * g;
    bf16x8 kf[16][2];
#pragma unroll
    for (int kt = 0; kt < 16; ++kt) {
        const GAS bf16_t* kp = kbase + (size_t)((kt >> 1) * 64 + (kt & 1) * 16) * PW;
        kf[kt][0] = *(const GAS bf16x8*)kp; kf[kt][1] = *(const GAS bf16x8*)(kp + 8);
    }
    SCHED_FENCE();
    f32x4 S[16];
#pragma unroll
    for (int kt = 0; kt < 16; ++kt) {
        f32x4 z = (f32x4){0.f, 0.f, 0.f, 0.f};
        z = mfma16(kf[kt][0], q0, z); S[kt] = mfma16(kf[kt][1], q1, z);
    }
    SCHED_FENCE();
    const GAS bf16_t* vbase = VT + (size_t)(VT_NAV + h * 64 + qi) * MTOK + (size_t)b * SEQ + rs0 * 64 + bs + 4 * g;
    u32x2 vf[8][4][2];
#pragma unroll
    for (int s = 0; s < 8; ++s)
#pragma unroll
        for (int dt = 0; dt < 4; ++dt) {
            const GAS bf16_t* vp = vbase + (size_t)dt * 16 * MTOK + s * 64;
            vf[s][dt][0] = *(const GAS u32x2*)vp; vf[s][dt][1] = *(const GAS u32x2*)(vp + 16);
        }
    SCHED_FENCE();
    float mx = -3.0e38f;
    const int dcb = bs - c + 15 + 4 * g, kcb = bs + 4 * g - cs;
#pragma unroll
    for (int kt = 0; kt < 16; ++kt) {
        const int dr = rs0 + (kt >> 1) - r + 7;
        const LAS float* brow = rpb + (h * 15 + dr) * 31;
#pragma unroll
        for (int i = 0; i < 4; ++i) {
            const int off = (kt & 1) * 16 + i;
            const bool valid = (unsigned)(kcb + off) < 16u;
            float bv = brow[min(max(dcb + off, 0), 30)];
            asm volatile("" : "+v"(bv));
            const float sv = valid ? __builtin_fmaf(S[kt][i], LOG2E, bv) : -1.0e30f;
            S[kt][i] = sv; mx = fmaxf(mx, sv);
        }
    }
    mx = fmaxf(mx, shx(mx, 16, lane)); mx = fmaxf(mx, shx(mx, 32, lane));
    float l = 0.f;
#pragma unroll
    for (int kt = 0; kt < 16; ++kt)
#pragma unroll
        for (int i = 0; i < 4; ++i) { const float pv = ex2(S[kt][i] - mx); S[kt][i] = pv; l += pv; }
    l += shx(l, 16, lane); l += shx(l, 32, lane);
    f32x4 O[4];
#pragma unroll
    for (int dt = 0; dt < 4; ++dt) O[dt] = (f32x4){0.f, 0.f, 0.f, 0.f};
#pragma unroll
    for (int s = 0; s < 8; ++s) {
        u32x4 pw; pw.x = cvt_pk_bf16(S[2 * s][0], S[2 * s][1]); pw.y = cvt_pk_bf16(S[2 * s][2], S[2 * s][3]);
        pw.z = cvt_pk_bf16(S[2 * s + 1][0], S[2 * s + 1][1]); pw.w = cvt_pk_bf16(S[2 * s + 1][2], S[2 * s + 1][3]);
        const bf16x8 pb = __builtin_bit_cast(bf16x8, pw);
#pragma unroll
        for (int dt = 0; dt < 4; ++dt) {
            u32x4 vw; vw.x = vf[s][dt][0].x; vw.y = vf[s][dt][0].y; vw.z = vf[s][dt][1].x; vw.w = vf[s][dt][1].y;
            O[dt] = mfma16(__builtin_bit_cast(bf16x8, vw), pb, O[dt]);
        }
    }
    const float inv = 1.0f / l;
    if (!DRY || l < 0.f)
#pragma unroll
    for (int dt = 0; dt < 4; ++dt) {
        u32x2 w; w.x = cvt_pk_bf16(O[dt][0] * inv, O[dt][1] * inv); w.y = cvt_pk_bf16(O[dt][2] * inv, O[dt][3] * inv);
        *(GAS u32x2*)(qp + dt * 16 + 4 * g) = w;
    }
}

__device__ __forceinline__ void r1_task(const GAS bf16_t* P, const GAS bf16_t* VT, GAS float* KV, int b, int n, int h, float lgf, float lgb, int wave, int lane) {
    const int g = lane >> 4, qi = lane & 15, mt = wave & 3, eh = wave >> 2;
    const size_t tok0 = (size_t)b * SEQ + n * 128;
    const GAS bf16_t* kp0 = P + (tok0 + 8 * g) * PW + PC_RK + h * 64 + mt * 16 + qi;
    const GAS bf16_t* vp0 = VT + (size_t)(VT_RV + h * 128 + eh * 64 + qi) * MTOK + tok0 + 8 * g;
    unsigned short kr[4][8]; bf16x8 Bv[4][4];
#pragma unroll
    for (int s = 0; s < 4; ++s)
#pragma unroll
        for (int i = 0; i < 8; ++i) kr[s][i] = kp0[(size_t)(32 * s + i) * PW];
#pragma unroll
    for (int s = 0; s < 4; ++s)
#pragma unroll
        for (int jn = 0; jn < 4; ++jn) Bv[s][jn] = *(const GAS bf16x8*)(vp0 + (size_t)jn * 16 * MTOK + 32 * s);
    SCHED_FENCE();
    f32x4 aF[4], aB[4];
#pragma unroll
    for (int j = 0; j < 4; ++j) { aF[j] = (f32x4){0.f, 0.f, 0.f, 0.f}; aB[j] = (f32x4){0.f, 0.f, 0.f, 0.f}; }
#pragma unroll
    for (int s = 0; s < 4; ++s) {
        u32x4 wf, wb;
        {
            float zf[8], zb[8];
#pragma unroll
            for (int i = 0; i < 8; ++i) { const int j = 32 * s + 8 * g + i; const float kf = bf2f(kr[s][i]); zf[i] = kf * ex2(lgf * (float)(127 - j)); zb[i] = kf * ex2(lgb * (float)j); }
            wf.x = cvt_pk_bf16(zf[0], zf[1]); wf.y = cvt_pk_bf16(zf[2], zf[3]); wf.z = cvt_pk_bf16(zf[4], zf[5]); wf.w = cvt_pk_bf16(zf[6], zf[7]);
            wb.x = cvt_pk_bf16(zb[0], zb[1]); wb.y = cvt_pk_bf16(zb[2], zb[3]); wb.z = cvt_pk_bf16(zb[4], zb[5]); wb.w = cvt_pk_bf16(zb[6], zb[7]);
        }
        const bf16x8 Af = __builtin_bit_cast(bf16x8, wf), Ab = __builtin_bit_cast(bf16x8, wb);
#pragma unroll
        for (int jn = 0; jn < 4; ++jn) { aF[jn] = mfma16(Af, Bv[s][jn], aF[jn]); aB[jn] = mfma16(Ab, Bv[s][jn], aB[jn]); }
    }
    const int unit = (b * 4 + h) * 64 + n;
    GAS float* kvf = KV + ((size_t)unit * 128) * 64;
    GAS float* kvb = KV + ((size_t)(1024 + unit) * 128) * 64;
#pragma unroll
    for (int jn = 0; jn < 4; ++jn) {
        const int e = (eh * 4 + jn) * 16 + qi, d = mt * 16 + 4 * g;
        *(GAS f32x4*)(kvf + e * 64 + d) = aF[jn]; *(GAS f32x4*)(kvb + e * 64 + d) = aB[jn];
    }
}

__device__ __forceinline__ bf16x8 scale_frag(bf16x8 q, float sc) {
    const u32x4 w = __builtin_bit_cast(u32x4, q); u32x4 o;
    o.x = cvt_pk_bf16(__uint_as_float(w.x << 16) * sc, __uint_as_float(w.x & 0xffff0000u) * sc); o.y = cvt_pk_bf16(__uint_as_float(w.y << 16) * sc, __uint_as_float(w.y & 0xffff0000u) * sc);
    o.z = cvt_pk_bf16(__uint_as_float(w.z << 16) * sc, __uint_as_float(w.z & 0xffff0000u) * sc); o.w = cvt_pk_bf16(__uint_as_float(w.w << 16) * sc, __uint_as_float(w.w & 0xffff0000u) * sc);
    return __builtin_bit_cast(bf16x8, o);
}
template <bool DRY = false>
__device__ __forceinline__ void r3_task(GAS bf16_t* P, const GAS bf16_t* VT, const GAS bf16_t* Sst, const GAS float* gain, int b, int n, int h, float lgf, float lgb, int wave, int lane) {
    const int g = lane >> 4, qi = lane & 15;
    const size_t tok0 = (size_t)b * SEQ + n * 128;
    const int iq = 16 * wave + qi; const size_t tokq = tok0 + iq;
    const GAS bf16_t* qp = P + tokq * PW + PC_RQ + h * 64 + 16 * g;
    const bf16x8 q0 = *(const GAS bf16x8*)qp, q1 = *(const GAS bf16x8*)(qp + 8);
    const GAS bf16_t* kbase = P + (tok0 + qi) * PW + PC_RK + h * 64 + 16 * g;
    bf16x8 kf[8][2];
#pragma unroll
    for (int jt = 0; jt < 8; ++jt) { const GAS bf16_t* kp = kbase + (size_t)(16 * jt) * PW; kf[jt][0] = *(const GAS bf16x8*)kp; kf[jt][1] = *(const GAS bf16x8*)(kp + 8); }
    const int unit = (b * 4 + h) * 64 + n;
    const GAS bf16_t* sf = Sst + ((size_t)unit * 128 + qi) * 64 + 16 * g;
    const GAS bf16_t* sb = Sst + ((size_t)(1024 + unit) * 128 + qi) * 64 + 16 * g;
    bf16x8 stf[8][2], stb[8][2];
#pragma unroll
    for (int et = 0; et < 8; ++et) { stf[et][0] = *(const GAS bf16x8*)(sf + et * 16 * 64); stf[et][1] = *(const GAS bf16x8*)(sf + et * 16 * 64 + 8); }
    SCHED_FENCE();
    f32x4 S[8];
#pragma unroll
    for (int jt = 0; jt < 8; ++jt) { f32x4 z = (f32x4){0.f, 0.f, 0.f, 0.f}; z = mfma16(kf[jt][0], q0, z); S[jt] = mfma16(kf[jt][1], q1, z); }
    SCHED_FENCE();
    const float xif = ex2(lgf * (float)(iq + 1)), xib = ex2(lgb * (float)(128 - iq));
    f32x4 O[8];
    {
        const bf16x8 qf0 = scale_frag(q0, xif), qf1 = scale_frag(q1, xif);
#pragma unroll
        for (int et = 0; et < 8; ++et) { f32x4 z = (f32x4){0.f, 0.f, 0.f, 0.f}; z = mfma16(stf[et][0], qf0, z); O[et] = mfma16(stf[et][1], qf1, z); }
    }
    SCHED_FENCE();
    const GAS bf16_t* vbase = VT + (size_t)(VT_RV + h * 128 + qi) * MTOK + tok0 + 4 * g;
    u32x2 vf[2][8][2];
#define R3_LOADV(buf, s_) do { _Pragma("unroll") for (int et = 0; et < 8; ++et) { const GAS bf16_t* vp = vbase + (size_t)et * 16 * MTOK + 32 * (s_); vf[buf][et][0] = *(const GAS u32x2*)vp; vf[buf][et][1] = *(const GAS u32x2*)(vp + 16); } } while (0)
#define R3_PV(buf, s_) do { u32x4 pw; pw.x = cvt_pk_bf16(S[2 * (s_)][0], S[2 * (s_)][1]); pw.y = cvt_pk_bf16(S[2 * (s_)][2], S[2 * (s_)][3]); \
        pw.z = cvt_pk_bf16(S[2 * (s_) + 1][0], S[2 * (s_) + 1][1]); pw.w = cvt_pk_bf16(S[2 * (s_) + 1][2], S[2 * (s_) + 1][3]); \
        const bf16x8 pb = __builtin_bit_cast(bf16x8, pw); \
        _Pragma("unroll") for (int et = 0; et < 8; ++et) { u32x4 vw; vw.x = vf[buf][et][0].x; vw.y = vf[buf][et][0].y; vw.z = vf[buf][et][1].x; vw.w = vf[buf][et][1].y; \
            O[et] = mfma16(__builtin_bit_cast(bf16x8, vw), pb, O[et]); } } while (0)
#pragma unroll
    for (int et = 0; et < 8; ++et) { stb[et][0] = *(const GAS bf16x8*)(sb + et * 16 * 64); stb[et][1] = *(const GAS bf16x8*)(sb + et * 16 * 64 + 8); }
    R3_LOADV(0, 0);
    SCHED_FENCE();
    int iqv = iq, gv = g; asm volatile("" : "+v"(iqv), "+v"(gv));
#pragma unroll
    for (int jt = 0; jt < 8; ++jt)
#pragma unroll
        for (int i = 0; i < 4; ++i) {
            const int j = 16 * jt + 4 * gv + i, diff = iqv - j;
            const float dd = diff >= 0 ? ex2(lgf * (float)diff) : ex2(lgb * (float)(-diff));
            S[jt][i] *= dd;
        }
    SCHED_FENCE();
    {
        const bf16x8 qb0 = scale_frag(q0, xib), qb1 = scale_frag(q1, xib);
#pragma unroll
        for (int et = 0; et < 8; ++et) { O[et] = mfma16(stb[et][0], qb0, O[et]); O[et] = mfma16(stb[et][1], qb1, O[et]); }
    }
    SCHED_FENCE();
    R3_LOADV(1, 1);
    GAS bf16_t* gp = P + tokq * PW + PC_GATE + h * 128 + 4 * g;
    const GAS float* gn = gain + h * 128 + 4 * g;
    u32x2 gwv[8];
#pragma unroll
    for (int et = 0; et < 8; ++et) gwv[et] = *(const GAS u32x2*)(gp + et * 16);
    SCHED_FENCE();
    R3_PV(0, 0); SCHED_FENCE();
    R3_LOADV(0, 2); SCHED_FENCE();
    R3_PV(1, 1); SCHED_FENCE();
    R3_LOADV(1, 3); SCHED_FENCE();
    R3_PV(0, 2); R3_PV(1, 3);
#undef R3_LOADV
#undef R3_PV
    float sum = 0.f;
#pragma unroll
    for (int et = 0; et < 8; ++et)
#pragma unroll
        for (int i = 0; i < 4; ++i) sum += O[et][i];
    sum += shx(sum, 16, lane); sum += shx(sum, 32, lane);
    const float mu = sum * (1.0f / 128.0f);
    float var = 0.f;
#pragma unroll
    for (int et = 0; et < 8; ++et)
#pragma unroll
        for (int i = 0; i < 4; ++i) { const float dlt = O[et][i] - mu; O[et][i] = dlt; var += dlt * dlt; }
    var += shx(var, 16, lane); var += shx(var, 32, lane);
    const float rstd = __builtin_amdgcn_rsqf(var * (1.0f / 128.0f) + GN_EPS);
    if (!DRY || rstd < 0.f)
#pragma unroll
    for (int et = 0; et < 8; ++et) {
        const u32x2 gw = gwv[et];
        const f32x4 ga = *(const GAS f32x4*)(gn + et * 16);
        float gt[4] = {__uint_as_float(gw.x << 16), __uint_as_float(gw.x & 0xffff0000u), __uint_as_float(gw.y << 16), __uint_as_float(gw.y & 0xffff0000u)};
        float o[4];
#pragma unroll
        for (int i = 0; i < 4; ++i) { const float sg = gt[i] * __builtin_amdgcn_rcpf(1.0f + ex2(-gt[i] * LOG2E)); o[i] = O[et][i] * rstd * ga[i] * sg; }
        u32x2 w; w.x = cvt_pk_bf16(o[0], o[1]); w.y = cvt_pk_bf16(o[2], o[3]);
        *(GAS u32x2*)(gp + et * 16) = w;
    }
}


constexpr int NA_KSTR = 144, NA_VSTR = 976, NA_V_OFF = 480 * NA_KSTR, NA_RPB_OFF = 131584, NA_UNITS = BATCH * 8 * 4 * 16;
static_assert(NA_V_OFF + 64 * NA_VSTR <= NA_RPB_OFF, "NA LDS map");
__device__ __forceinline__ void na_phase(GAS bf16_t* P, const GAS bf16_t* VT, const GAS float* rpb_g, LAS unsigned char* lds, int G, int bx, int vcu, int tid, int wave, int lane) {
    LAS float* rpbL = (LAS float*)(lds + NA_RPB_OFF);
    for (int i = tid; i < 8 * 15 * 31; i += NTHREADS) rpbL[i] = rpb_g[i] * LOG2E;
    const int g = lane >> 4, qi = lane & 15;
    const bool xmap = (G == 256);
    const int nun = xmap ? NA_UNITS / 256 : (NA_UNITS - bx + G - 1) / G;
#define NA_UNIT(i) (xmap ? ((vcu >> 5) * (NA_UNITS / 8) + (i) * 32 + (vcu & 31)) : (bx + (i) * G))
    u32x4 pk[8], pv[8]; bf16x8 pq0, pq1;
#define NA_PREFETCH(u_) do { const int h_ = (u_) & 7, cb_ = ((u_) >> 3) & 3, rg_ = ((u_) >> 5) & 15, b_ = (u_) >> 9; \
        const int rlo_ = min(max(rg_ * 8 - 4, 0), 113), bs_ = min(max(cb_ * 16 - 8, 0), 32); \
        const GAS bf16_t* kb_ = P + ((size_t)b_ * SEQ + rlo_ * 64 + bs_) * PW + PC_NAK + h_ * 64; \
        const GAS bf16_t* vb_ = VT + (size_t)(VT_NAV + h_ * 64) * MTOK + (size_t)b_ * SEQ + rlo_ * 64 + bs_; \
        _Pragma("unroll") for (int j = 0; j < 8; ++j) { const int c_ = tid + NTHREADS * j; if (j < 7 || c_ < 3840) { \
            const int kk_ = c_ >> 3; pk[j] = *(const GAS u32x4*)(kb_ + (size_t)((kk_ >> 5) * 64 + (kk_ & 31)) * PW + (c_ & 7) * 8); \
            pv[j] = *(const GAS u32x4*)(vb_ + (size_t)((c_ >> 2) & 63) * MTOK + (c_ >> 8) * 64 + (c_ & 3) * 8); } } \
        const GAS bf16_t* qp_ = P + ((size_t)b_ * SEQ + (rg_ * 8 + wave) * 64 + cb_ * 16 + qi) * PW + PC_NAQ + h_ * 64 + 16 * g; \
        pq0 = *(const GAS bf16x8*)qp_; pq1 = *(const GAS bf16x8*)(qp_ + 8); } while (0)
#ifndef NA_NOPF
    NA_PREFETCH(NA_UNIT(0));
#endif
    for (int it = 0; it < nun; ++it) {
        const int u = NA_UNIT(it);
#ifdef NA_NOPF
        NA_PREFETCH(u);
#endif
        __syncthreads();
#pragma unroll
        for (int j = 0; j < 8; ++j) { const int c_ = tid + NTHREADS * j; if (j < 7 || c_ < 3840) {
            *(LAS u32x4*)(lds + (c_ >> 3) * NA_KSTR + (c_ & 7) * 16) = pk[j];
            *(LAS u32x4*)(lds + NA_V_OFF + ((c_ >> 2) & 63) * NA_VSTR + (c_ >> 8) * 64 + (c_ & 3) * 16) = pv[j]; } }
        const bf16x8 q0 = pq0, q1 = pq1;
        __syncthreads();
#ifndef NA_NOPF
        if (it + 1 < nun) NA_PREFETCH(NA_UNIT(it + 1));
#endif
        SCHED_FENCE();
        const int h = u & 7, cb = (u >> 3) & 3, rg = (u >> 5) & 15, b = u >> 9;
        const int rlo = min(max(rg * 8 - 4, 0), 113), bs = min(max(cb * 16 - 8, 0), 32);
        const int r = rg * 8 + wave, rs0 = min(max(r - 4, 0), 120), krow0 = rs0 - rlo;
        const int c = cb * 16 + qi, cs = min(max(c - 8, 0), 48);
        f32x4 S[16];
        const LAS unsigned char* ka = lds + (krow0 * 32 + qi) * NA_KSTR + g * 32;
#pragma unroll
        for (int kt = 0; kt < 16; ++kt) {
            const LAS unsigned char* kp = ka + ((kt >> 1) * 32 + (kt & 1) * 16) * NA_KSTR;
            const bf16x8 k0 = *(const LAS bf16x8*)kp, k1 = *(const LAS bf16x8*)(kp + 16);
            f32x4 z = (f32x4){0.f, 0.f, 0.f, 0.f};
            z = mfma16(k0, q0, z); S[kt] = mfma16(k1, q1, z);
        }
        float mx = -3.0e38f;
        const int dcb = bs - c + 15 + 4 * g, kcb = bs + 4 * g - cs;
        bool v0[4]; int dci[4];
#pragma unroll
        for (int i = 0; i < 4; ++i) { v0[i] = (unsigned)(kcb + i) < 16u; dci[i] = dcb + i + (v0[i] ? 0 : 16); }
        const LAS float* brow0 = rpbL + (h * 15 + (rs0 - r + 7)) * 31;
#pragma unroll
        for (int kr = 0; kr < 8; ++kr)
#pragma unroll
            for (int i = 0; i < 4; ++i) {
                const float sv = v0[i] ? S[2 * kr][i] : S[2 * kr + 1][i];
                const float tv = __builtin_fmaf(sv, LOG2E, brow0[kr * 31 + dci[i]]);
                S[2 * kr][i] = tv; mx = fmaxf(mx, tv);
            }
        mx = fmaxf(mx, shx(mx, 16, lane)); mx = fmaxf(mx, shx(mx, 32, lane));
        float l = 0.f;
#pragma unroll
        for (int kr = 0; kr < 8; ++kr)
#pragma unroll
            for (int i = 0; i < 4; ++i) { const float pvv = ex2(S[2 * kr][i] - mx); l += pvv; S[2 * kr][i] = v0[i] ? pvv : 0.f; S[2 * kr + 1][i] = v0[i] ? 0.f : pvv; }
        l += shx(l, 16, lane); l += shx(l, 32, lane);
        f32x4 O[4];
#pragma unroll
        for (int dt = 0; dt < 4; ++dt) O[dt] = (f32x4){0.f, 0.f, 0.f, 0.f};
        const LAS unsigned char* va = lds + NA_V_OFF + qi * NA_VSTR + (krow0 * 32 + 4 * g) * 2;
#pragma unroll
        for (int s = 0; s < 8; ++s) {
            u32x4 pw; pw.x = cvt_pk_bf16(S[2 * s][0], S[2 * s][1]); pw.y = cvt_pk_bf16(S[2 * s][2], S[2 * s][3]);
            pw.z = cvt_pk_bf16(S[2 * s + 1][0], S[2 * s + 1][1]); pw.w = cvt_pk_bf16(S[2 * s + 1][2], S[2 * s + 1][3]);
            const bf16x8 pb = __builtin_bit_cast(bf16x8, pw);
#pragma unroll
            for (int dt = 0; dt < 4; ++dt) {
                const LAS unsigned char* vp = va + dt * 16 * NA_VSTR + s * 64;
                const u32x2 lo = *(const LAS u32x2*)vp, hi = *(const LAS u32x2*)(vp + 32);
                u32x4 vw; vw.x = lo.x; vw.y = lo.y; vw.z = hi.x; vw.w = hi.y;
                O[dt] = mfma16(__builtin_bit_cast(bf16x8, vw), pb, O[dt]);
            }
        }
        const float inv = 1.0f / l;
        GAS bf16_t* qp = P + ((size_t)b * SEQ + r * 64 + c) * PW + PC_NAQ + h * 64;
#pragma unroll
        for (int dt = 0; dt < 4; ++dt) {
            u32x2 w; w.x = cvt_pk_bf16(O[dt][0] * inv, O[dt][1] * inv); w.y = cvt_pk_bf16(O[dt][2] * inv, O[dt][3] * inv);
            *(GAS u32x2*)(qp + dt * 16 + 4 * g) = w;
        }
    }
#undef NA_PREFETCH
#undef NA_UNIT
}


constexpr int R3_KSTR = 144, R3_VSTR = 272, R3_K_OFF = 0, R3_V_OFF = 128 * R3_KSTR, R3_F_OFF = R3_V_OFF + 128 * R3_VSTR, R3_B_OFF = R3_F_OFF + 128 * R3_KSTR;
static_assert(R3_B_OFF + 128 * R3_KSTR <= 131072, "R3 LDS map");
__device__ __forceinline__ void r3_phase(GAS bf16_t* P, const GAS bf16_t* VT, const GAS bf16_t* Sst, const GAS float* gain, const GAS float* dfw, const GAS float* dbw, LAS unsigned char* lds, int G, int vcu, int tid, int wave, int lane) {
    const int g = lane >> 4, qi = lane & 15;
    for (int u = vcu; u < 1024; u += G) {
        const int bh = u >> 6, n = u & 63, b = bh >> 2, h = bh & 3;
        const float lgf = log2_decay(dfw[h]), lgb = log2_decay(dbw[h]);
        const size_t tok0 = (size_t)b * SEQ + n * 128;
        const int iq = 16 * wave + qi; const size_t tokq = tok0 + iq;
        u32x4 sk[2], sv[4], sf2[2], sb2[2];
#pragma unroll
        for (int j = 0; j < 2; ++j) { const int c = tid + NTHREADS * j; sk[j] = *(const GAS u32x4*)(P + (tok0 + (c >> 3)) * PW + PC_RK + h * 64 + (c & 7) * 8); }
#pragma unroll
        for (int j = 0; j < 4; ++j) { const int c = tid + NTHREADS * j; sv[j] = *(const GAS u32x4*)(VT + (size_t)(VT_RV + h * 128 + (c >> 4)) * MTOK + tok0 + (c & 15) * 8); }
#pragma unroll
        for (int j = 0; j < 2; ++j) { const int c = tid + NTHREADS * j; sf2[j] = *(const GAS u32x4*)(Sst + (size_t)u * 8192 + (size_t)c * 8); sb2[j] = *(const GAS u32x4*)(Sst + (size_t)(1024 + u) * 8192 + (size_t)c * 8); }
        const GAS bf16_t* qp = P + tokq * PW + PC_RQ + h * 64 + 16 * g;
        const bf16x8 q0 = *(const GAS bf16x8*)qp, q1 = *(const GAS bf16x8*)(qp + 8);
        GAS bf16_t* gp = P + tokq * PW + PC_GATE + h * 128 + 4 * g;
        const GAS float* gn = gain + h * 128 + 4 * g;
        u32x2 gwv[8];
#pragma unroll
        for (int et = 0; et < 8; ++et) gwv[et] = *(const GAS u32x2*)(gp + et * 16);
        __syncthreads();
#pragma unroll
        for (int j = 0; j < 2; ++j) { const int c = tid + NTHREADS * j; *(LAS u32x4*)(lds + R3_K_OFF + (c >> 3) * R3_KSTR + (c & 7) * 16) = sk[j];
            *(LAS u32x4*)(lds + R3_F_OFF + (c >> 3) * R3_KSTR + (c & 7) * 16) = sf2[j]; *(LAS u32x4*)(lds + R3_B_OFF + (c >> 3) * R3_KSTR + (c & 7) * 16) = sb2[j]; }
#pragma unroll
        for (int j = 0; j < 4; ++j) { const int c = tid + NTHREADS * j; *(LAS u32x4*)(lds + R3_V_OFF + (c >> 4) * R3_VSTR + (c & 15) * 16) = sv[j]; }
        __syncthreads();
        f32x4 S[8];
#pragma unroll
        for (int jt = 0; jt < 8; ++jt) {
            const LAS unsigned char* kp = lds + R3_K_OFF + (16 * jt + qi) * R3_KSTR + g * 32;
            const bf16x8 k0 = *(const LAS bf16x8*)kp, k1 = *(const LAS bf16x8*)(kp + 16);
            f32x4 z = (f32x4){0.f, 0.f, 0.f, 0.f}; z = mfma16(k0, q0, z); S[jt] = mfma16(k1, q1, z);
        }
        int iqv = iq, gv = g; asm volatile("" : "+v"(iqv), "+v"(gv));
#pragma unroll
        for (int jt = 0; jt < 8; ++jt)
#pragma unroll
            for (int i = 0; i < 4; ++i) {
                const int j = 16 * jt + 4 * gv + i, diff = iqv - j;
                const float dd = diff >= 0 ? ex2(lgf * (float)diff) : ex2(lgb * (float)(-diff));
                S[jt][i] *= dd;
            }
        const float xif = ex2(lgf * (float)(iq + 1)), xib = ex2(lgb * (float)(128 - iq));
        const bf16x8 qf0 = scale_frag(q0, xif), qf1 = scale_frag(q1, xif), qb0 = scale_frag(q0, xib), qb1 = scale_frag(q1, xib);
        f32x4 O[8];
#pragma unroll
        for (int et = 0; et < 8; ++et) {
            const LAS unsigned char* fp = lds + R3_F_OFF + (et * 16 + qi) * R3_KSTR + g * 32;
            const LAS unsigned char* bp = lds + R3_B_OFF + (et * 16 + qi) * R3_KSTR + g * 32;
            f32x4 z = (f32x4){0.f, 0.f, 0.f, 0.f};
            z = mfma16(*(const LAS bf16x8*)fp, qf0, z); z = mfma16(*(const LAS bf16x8*)(fp + 16), qf1, z);
            z = mfma16(*(const LAS bf16x8*)bp, qb0, z); O[et] = mfma16(*(const LAS bf16x8*)(bp + 16), qb1, z);
        }
#pragma unroll
        for (int s = 0; s < 4; ++s) {
            u32x4 pw; pw.x = cvt_pk_bf16(S[2 * s][0], S[2 * s][1]); pw.y = cvt_pk_bf16(S[2 * s][2], S[2 * s][3]);
            pw.z = cvt_pk_bf16(S[2 * s + 1][0], S[2 * s + 1][1]); pw.w = cvt_pk_bf16(S[2 * s + 1][2], S[2 * s + 1][3]);
            const bf16x8 pb = __builtin_bit_cast(bf16x8, pw);
#pragma unroll
            for (int et = 0; et < 8; ++et) {
                const LAS unsigned char* vp = lds + R3_V_OFF + (et * 16 + qi) * R3_VSTR + (32 * s + 4 * g) * 2;
                const u32x2 lo = *(const LAS u32x2*)vp, hi = *(const LAS u32x2*)(vp + 32);
                u32x4 vw; vw.x = lo.x; vw.y = lo.y; vw.z = hi.x; vw.w = hi.y;
                O[et] = mfma16(__builtin_bit_cast(bf16x8, vw), pb, O[et]);
            }
        }
        float sum = 0.f;
#pragma unroll
        for (int et = 0; et < 8; ++et)
#pragma unroll
            for (int i = 0; i < 4; ++i) sum += O[et][i];
        sum += shx(sum, 16, lane); sum += shx(sum, 32, lane);
        const float mu = sum * (1.0f / 128.0f);
        float var = 0.f;
#pragma unroll
        for (int et = 0; et < 8; ++et)
#pragma unroll
            for (int i = 0; i < 4; ++i) { const float dlt = O[et][i] - mu; O[et][i] = dlt; var += dlt * dlt; }
        var += shx(var, 16, lane); var += shx(var, 32, lane);
        const float rstd = __builtin_amdgcn_rsqf(var * (1.0f / 128.0f) + GN_EPS);
#pragma unroll
        for (int et = 0; et < 8; ++et) {
            const u32x2 gw = gwv[et];
            const f32x4 ga = *(const GAS f32x4*)(gn + et * 16);
            float gt[4] = {__uint_as_float(gw.x << 16), __uint_as_float(gw.x & 0xffff0000u), __uint_as_float(gw.y << 16), __uint_as_float(gw.y & 0xffff0000u)};
            float o[4];
#pragma unroll
            for (int i = 0; i < 4; ++i) { const float sg = gt[i] * __builtin_amdgcn_rcpf(1.0f + ex2(-gt[i] * LOG2E)); o[i] = O[et][i] * rstd * ga[i] * sg; }
            u32x2 w; w.x = cvt_pk_bf16(o[0], o[1]); w.y = cvt_pk_bf16(o[2], o[3]);
            *(GAS u32x2*)(gp + et * 16) = w;
        }
    }
}


__device__ __forceinline__ void r1_phase(const GAS bf16_t* P, const GAS bf16_t* VT, GAS float* KV, const GAS float* dfw, const GAS float* dbw, LAS unsigned char* lds, int G, int vcu, int tid, int wave, int lane) {
    const int g = lane >> 4, qi = lane & 15, mt = wave & 3, eh = wave >> 2;
    for (int u = vcu; u < 1024; u += G) {
        const int bh = u >> 6, n = u & 63, b = bh >> 2, h = bh & 3;
        const float lgf = log2_decay(dfw[h]), lgb = log2_decay(dbw[h]);
        const size_t tok0 = (size_t)b * SEQ + n * 128;
        u32x4 sk[2], sv[4];
#pragma unroll
        for (int j = 0; j < 2; ++j) { const int c = tid + NTHREADS * j; sk[j] = *(const GAS u32x4*)(P + (tok0 + (c >> 3)) * PW + PC_RK + h * 64 + (c & 7) * 8); }
#pragma unroll
        for (int j = 0; j < 4; ++j) { const int c = tid + NTHREADS * j; sv[j] = *(const GAS u32x4*)(VT + (size_t)(VT_RV + h * 128 + (c >> 4)) * MTOK + tok0 + (c & 15) * 8); }
        __syncthreads();
#pragma unroll
        for (int j = 0; j < 2; ++j) { const int c = tid + NTHREADS * j; *(LAS u32x4*)(lds + R3_K_OFF + (c >> 3) * R3_KSTR + (c & 7) * 16) = sk[j]; }
#pragma unroll
        for (int j = 0; j < 4; ++j) { const int c = tid + NTHREADS * j; *(LAS u32x4*)(lds + R3_V_OFF + (c >> 4) * R3_VSTR + (c & 15) * 16) = sv[j]; }
        __syncthreads();
        f32x4 aF[4], aB[4];
#pragma unroll
        for (int j = 0; j < 4; ++j) { aF[j] = (f32x4){0.f, 0.f, 0.f, 0.f}; aB[j] = (f32x4){0.f, 0.f, 0.f, 0.f}; }
        int gv = g; asm volatile("" : "+v"(gv));
#pragma unroll
        for (int s = 0; s < 4; ++s) {
            float zf[8], zb[8];
            const LAS unsigned char* kp = lds + R3_K_OFF + (32 * s + 8 * gv) * R3_KSTR + (mt * 16 + qi) * 2;
#pragma unroll
            for (int i = 0; i < 8; ++i) { const int j = 32 * s + 8 * gv + i; const float kf = bf2f(*(const LAS unsigned short*)(kp + i * R3_KSTR)); zf[i] = kf * ex2(lgf * (float)(127 - j)); zb[i] = kf * ex2(lgb * (float)j); }
            u32x4 wf, wb;
            wf.x = cvt_pk_bf16(zf[0], zf[1]); wf.y = cvt_pk_bf16(zf[2], zf[3]); wf.z = cvt_pk_bf16(zf[4], zf[5]); wf.w = cvt_pk_bf16(zf[6], zf[7]);
            wb.x = cvt_pk_bf16(zb[0], zb[1]); wb.y = cvt_pk_bf16(zb[2], zb[3]); wb.z = cvt_pk_bf16(zb[4], zb[5]); wb.w = cvt_pk_bf16(zb[6], zb[7]);
            const bf16x8 Af = __builtin_bit_cast(bf16x8, wf), Ab = __builtin_bit_cast(bf16x8, wb);
#pragma unroll
            for (int jn = 0; jn < 4; ++jn) {
                const bf16x8 Bv = *(const LAS bf16x8*)(lds + R3_V_OFF + ((eh * 4 + jn) * 16 + qi) * R3_VSTR + (32 * s + 8 * g) * 2);
                aF[jn] = mfma16(Af, Bv, aF[jn]); aB[jn] = mfma16(Ab, Bv, aB[jn]);
            }
        }
        GAS float* kvf = KV + ((size_t)u * 128) * 64;
        GAS float* kvb = KV + ((size_t)(1024 + u) * 128) * 64;
#pragma unroll
        for (int jn = 0; jn < 4; ++jn) {
            const int e = (eh * 4 + jn) * 16 + qi, d = mt * 16 + 4 * g;
            *(GAS f32x4*)(kvf + e * 64 + d) = aF[jn]; *(GAS f32x4*)(kvb + e * 64 + d) = aB[jn];
        }
    }
}

#define RLX_AGENT __ATOMIC_RELAXED, __HIP_MEMORY_SCOPE_AGENT
#define XB_TMO      128
#define XB_XCNT(j)  (256  + 64 * (j))
#define XB_XSUB(j)  (1280 + 64 * (j))
#define XB_XGEN(j)  (2304 + 64 * (j))
#define XB_TOP      3328
#define XB_TOPGEN   3392
#define XCD_BAR_WORDS 3456
#define XB_SPIN_CAP (1u << 18)

__device__ __forceinline__ unsigned xb_ld(unsigned* p)              { return __hip_atomic_load(p, __ATOMIC_RELAXED, __HIP_MEMORY_SCOPE_AGENT); }
__device__ __forceinline__ unsigned xb_add(unsigned* p, unsigned v) { return __hip_atomic_fetch_add(p, v, __ATOMIC_RELAXED, __HIP_MEMORY_SCOPE_AGENT); }
__device__ __forceinline__ unsigned xb_xcc_id() { return (unsigned)__builtin_amdgcn_s_getreg((3 << 11) | 20) & 0xFu; }
#define XB_SPIN(cond, bar) do { unsigned _sp = 0; while (cond) { __builtin_amdgcn_s_sleep(1); \
    if ((++_sp & 255u) == 0u) { if (xb_ld(&(bar)[XB_TMO])) break; if (_sp > XB_SPIN_CAP) { atomicAdd(&(bar)[XB_TMO], 1u); break; } } } } while (0)

struct XcdBarrier {
    bool t0;
    unsigned* bar; unsigned x;
    volatile LAS unsigned* st;
};

__device__ __forceinline__ XcdBarrier xcd_barrier_post(unsigned* bar, volatile LAS unsigned* st) {
    XcdBarrier b; b.bar = bar; b.x = xb_xcc_id(); b.st = st; b.t0 = (threadIdx.x == 0);
    if (threadIdx.x == 0) (void)xb_add(&bar[XB_XCNT(b.x)], 1u);
    return b;
}
__device__ __forceinline__ void xcd_barrier_complete(unsigned* bar, unsigned x, unsigned& nloc, unsigned& nx) {
    const unsigned G = gridDim.x * gridDim.y * gridDim.z;
    unsigned sum, cnt, mine, sp = 0u;
    for (;;) {
        sum = 0u; cnt = 0u; mine = 0u;
#pragma unroll
        for (unsigned j = 0; j < 16; ++j) { const unsigned c = xb_ld(&bar[XB_XCNT(j)]); sum += c; cnt += (c > 0u) ? 1u : 0u; mine = (j == x) ? c : mine; }
        if (sum == G) break;
        __builtin_amdgcn_s_sleep(1);
        if ((++sp & 255u) == 0u) { if (xb_ld(&bar[XB_TMO])) break; if (sp > XB_SPIN_CAP) { atomicAdd(&bar[XB_TMO], 1u); break; } }
    }
    nloc = mine > 0u ? mine : 1u; nx = cnt > 0u ? cnt : 1u;
}

__device__ __forceinline__ void xcd_barrier(const XcdBarrier& b) {
    asm volatile("s_waitcnt vmcnt(0)" ::: "memory");
    __syncthreads();
    if (b.t0) {
        unsigned* bar = b.bar;
        __builtin_amdgcn_s_waitcnt(0);
        unsigned nloc = b.st[0], nx = b.st[1];
        if (nloc == 0u) { xcd_barrier_complete(bar, b.x, nloc, nx); b.st[0] = nloc; b.st[1] = nx; }
        const unsigned old = xb_add(&bar[XB_XSUB(b.x)], 1u);
        const unsigned gen = old / nloc;
        if (old + 1u == (gen + 1u) * nloc) {
            __builtin_amdgcn_fence(__ATOMIC_RELEASE, "agent");
            asm volatile("s_waitcnt vmcnt(0)" ::: "memory");
            const unsigned og = xb_add(&bar[XB_TOP], 1u);
            const unsigned tg = og / nx;
            if (og + 1u == (tg + 1u) * nx) xb_add(&bar[XB_TOPGEN], 1u);
            else XB_SPIN(xb_ld(&bar[XB_TOPGEN]) == tg, bar);
            __builtin_amdgcn_fence(__ATOMIC_ACQUIRE, "agent");
            xb_add(&bar[XB_XGEN(b.x)], 1u);
            asm volatile("s_waitcnt vmcnt(0)" ::: "memory");
        } else {
            XB_SPIN(xb_ld(&bar[XB_XGEN(b.x)]) == gen, bar);
            __builtin_amdgcn_fence(__ATOMIC_ACQUIRE, "agent");
            asm volatile("s_waitcnt vmcnt(0)" ::: "memory");
        }
    }
    __syncthreads();
}

__global__ void __launch_bounds__(NTHREADS, 2) fwd_megakernel(Params p) {
    extern __shared__ __attribute__((aligned(16))) unsigned char lds_raw[];
    LAS unsigned char* lds = (LAS unsigned char*)lds_raw;
typedef const __attribute__((address_space(4))) Params* KP;
#define FRESH_P() ({ KP _q = (KP)__builtin_amdgcn_kernarg_segment_ptr(); asm volatile("" : "+s"(_q)); _q; })
#define FRESH_WS() ({ KP _q = FRESH_P(); unsigned char* _w = _q->ws; asm volatile("" : "+s"(_w)); (GAS unsigned char*)_w; })
    cg::grid_group grid = cg::this_grid();
    const int wave0 = __builtin_amdgcn_readfirstlane(threadIdx.x >> 6);
    for (int u = threadIdx.x; u < (LDS_BYTES - LDSCTL_OFF) / 4; u += NTHREADS) ((LAS unsigned*)(lds + LDSCTL_OFF))[u] = 0u;
    static_assert(LDSCTL_OFF >= 131584 + 8 * 15 * 31 * 4 && MISC_OFF + 32 + 8 <= LDS_BYTES, "LDS map");
    __syncthreads();
    { KP q0 = FRESH_P(); (void)xcd_barrier_post((unsigned*)(q0->ws + WS_BAR), (volatile LAS unsigned*)(lds + MISC_OFF + 32)); }
#define GRID_BAR() do { XcdBarrier _b; _b.t0 = (wave0 == 0) && (lane_opaque() == 0); _b.bar = (unsigned*)(FRESH_WS() + WS_BAR); _b.x = xb_xcc_id(); _b.st = (volatile LAS unsigned*)(lds + MISC_OFF + 32); xcd_barrier(_b); } while (0)
#define IDS() int w0_ = wave0; asm volatile("" : "+s"(w0_)); int tid = w0_ * 64 + lane_opaque(); int G = gridDim.x; asm volatile("" : "+s"(G)); \
    const int lane = tid & 63, wave = __builtin_amdgcn_readfirstlane(tid >> 6), bx = blockIdx.x; \
    const int vcu = (G % 8 == 0) ? (bx % 8) * (G / 8) + bx / 8 : bx;   \
    const int gw = vcu * NWAVES + wave, NGW = G * NWAVES, gtid = bx * NTHREADS + tid, NT = G * NTHREADS; \
    (void)lane; (void)wave; (void)vcu; (void)gw; (void)NGW; (void)gtid; (void)NT;
#define rowssA ((GAS unsigned long long*)(ws + WS_ROWSSA))
#define rowssB ((GAS unsigned long long*)(ws + WS_ROWSSB))
#define cost ((GAS float*)(ws + WS_COS))
#define sint ((GAS float*)(ws + WS_SIN))
#define Wc ((GAS bf16_t*)(ws + WS_W))
#define XB ((GAS bf16_t*)(ws + WS_XB))
#define KV ((GAS float*)(ws + WS_KV))
#define P ((GAS bf16_t*)(ws + WS_P))
#define VT ((GAS bf16_t*)(ws + WS_VT))
#define Sst ((GAS bf16_t*)(ws + WS_S))
#define U ((GAS bf16_t*)(ws + WS_U))

    {
        IDS(); GAS unsigned char* ws = FRESH_WS(); KP kp = FRESH_P(); (void)kp;
        LAS float* scr = (LAS float*)(lds + wave * 16384);
        constexpr int I_IN = 16 * 96, I_OUT = 16 * 32, I_UP = 16 * 128, I_DN = 64 * 32, I_L = I_IN + I_OUT + I_UP + I_DN;
#define WI_DECODE(it_, SRC, GN, DST, NN, KK, CS) do { const int l_ = (it_) / I_L; int r_ = (it_) % I_L; GAS bf16_t* wl_ = Wc + (size_t)l_ * LAYER_W; const GAS float* W_; GAS bf16_t* T_; int mode_ = 0; \
            if (r_ < I_IN) { W_ = ((const GAS float*)kp->w_in) + (size_t)l_ * 1024 * 3072; NN = 3072; KK = 1024; T_ = wl_ + OFF_IN; GN = ((const GAS float*)kp->nmix) + l_ * 1024; mode_ = 1; } \
            else if ((r_ -= I_IN) < I_OUT) { W_ = ((const GAS float*)kp->w_out) + (size_t)l_ * 1024 * 1024; NN = 1024; KK = 1024; T_ = wl_ + OFF_OUT; GN = nullptr; } \
            else if ((r_ -= I_OUT) < I_UP) { W_ = ((const GAS float*)kp->w_up) + (size_t)l_ * 1024 * 4096; NN = 4096; KK = 1024; T_ = wl_ + OFF_UP; GN = ((const GAS float*)kp->nmlp) + l_ * 1024; } \
            else { r_ -= I_UP; W_ = ((const GAS float*)kp->w_down) + (size_t)l_ * 4096 * 1024; NN = 1024; KK = 4096; T_ = wl_ + OFF_DN; GN = nullptr; } \
            const int nblk_ = NN / 32, k0_ = 64 * (r_ / nblk_), n0_ = 32 * (r_ % nblk_); CS = 1.f; int sc_ = n0_ + (lane & 31); if (mode_) sc_ = srccol_in(n0_ + (lane & 31), CS); \
            SRC = W_ + (size_t)(k0_ + (lane >> 5)) * NN + sc_; if (GN) GN += k0_ + (lane >> 5); DST = T_ + (size_t)(n0_ + (lane >> 3)) * KK + k0_ + 8 * (lane & 7); } while (0)
        {
            const int total = DEPTH * I_L;
            const GAS float* srcA = nullptr; const GAS float* gnA = nullptr; GAS bf16_t* dstA = nullptr; int nA_ = 0, kA_ = 0; float csA = 1.f;
            float wv[32];
            int it = gw;
            if (it < total) { WI_DECODE(it, srcA, gnA, dstA, nA_, kA_, csA);
#pragma unroll
                for (int i = 0; i < 32; ++i) wv[i] = srcA[(size_t)(2 * i) * nA_]; }
            while (it < total) {
                const int nx = it + NGW;
                const GAS float* srcB = nullptr; const GAS float* gnB = nullptr; GAS bf16_t* dstB = nullptr; int nB_ = 0, kB_ = 0; float csB = 1.f;
                float wn[32];
                if (nx < total) { WI_DECODE(nx, srcB, gnB, dstB, nB_, kB_, csB);
#pragma unroll
                    for (int i = 0; i < 32; ++i) wn[i] = srcB[(size_t)(2 * i) * nB_]; }
#pragma unroll
                for (int i = 0; i < 32; ++i) { const float gq = gnA ? gnA[2 * i] * csA : csA; scr[(2 * i + (lane >> 5)) * 33 + (lane & 31)] = wv[i] * gq; }
                asm volatile("s_waitcnt lgkmcnt(0)" ::: "memory");
                { const int c = lane & 7;
#pragma unroll
                  for (int j = 0; j < 4; ++j) { const int n = (lane >> 3) + 8 * j; const LAS float* sp = scr + (8 * c) * 33 + n;
                    u32x4 o; o.x = cvt_pk_bf16(sp[0 * 33], sp[1 * 33]); o.y = cvt_pk_bf16(sp[2 * 33], sp[3 * 33]); o.z = cvt_pk_bf16(sp[4 * 33], sp[5 * 33]); o.w = cvt_pk_bf16(sp[6 * 33], sp[7 * 33]);
                    *(GAS u32x4*)(dstA + (size_t)(8 * j) * kA_) = o; } }
                asm volatile("s_waitcnt lgkmcnt(0)" ::: "memory");
                if (nx < total) {
#pragma unroll
                    for (int i = 0; i < 32; ++i) wv[i] = wn[i];
                    srcA = srcB; gnA = gnB; dstA = dstB; nA_ = nB_; kA_ = kB_; csA = csB; }
                it = nx;
            }
        }
#undef WI_DECODE
        for (int m = gw; m < MTOK; m += 2 * NGW) {
            const int m2 = m + NGW; const bool has2 = m2 < MTOK;
            const GAS f32x4* xr = (const GAS f32x4*)(((const GAS float*)kp->x) + (size_t)m * DM) + lane;
            const GAS f32x4* xr2 = (const GAS f32x4*)(((const GAS float*)kp->x) + (size_t)(has2 ? m2 : m) * DM) + lane;
            f32x4 v[4], v2[4]; float s = 0.f, s2 = 0.f;
#pragma unroll
            for (int j = 0; j < 4; ++j) { v[j] = xr[64 * j]; v2[j] = xr2[64 * j]; }
#pragma unroll
            for (int j = 0; j < 4; ++j) { s += (v[j][0] * v[j][0] + v[j][1] * v[j][1]) + (v[j][2] * v[j][2] + v[j][3] * v[j][3]); s2 += (v2[j][0] * v2[j][0] + v2[j][1] * v2[j][1]) + (v2[j][2] * v2[j][2] + v2[j][3] * v2[j][3]); }
            s = wave_sum(s, lane); s2 = wave_sum(s2, lane);
            if (lane == 0) { rowssB[m] = (unsigned long long)(s * pg8::SS_SCALE + 0.5f); if (has2) rowssB[m2] = (unsigned long long)(s2 * pg8::SS_SCALE + 0.5f); }
            GAS u32x2* o8 = (GAS u32x2*)(XB + (size_t)m * DM) + lane;
#pragma unroll
            for (int j = 0; j < 4; ++j) { u32x2 w; w.x = cvt_pk_bf16(v[j][0], v[j][1]); w.y = cvt_pk_bf16(v[j][2], v[j][3]); o8[64 * j] = w; }
            if (has2) { GAS u32x2* o82 = (GAS u32x2*)(XB + (size_t)m2 * DM) + lane;
#pragma unroll
                for (int j = 0; j < 4; ++j) { u32x2 w; w.x = cvt_pk_bf16(v2[j][0], v2[j][1]); w.y = cvt_pk_bf16(v2[j][2], v2[j][3]); o82[64 * j] = w; } }
        }
        for (int idx = gtid; idx < SEQ * 32; idx += NT) {
            const int pos = idx >> 5, i = idx & 31;
            double f = kp->inv2pi0; for (int k = 0; k < i; ++k) f *= kp->rbase;
            double a = (double)pos * f; a -= floor(a);
            const float fr = (float)a;
            cost[idx] = __builtin_amdgcn_cosf(fr); sint[idx] = __builtin_amdgcn_sinf(fr);
        }
    }
    if (gridDim.x == 0u) grid.sync();
    GRID_BAR();

#pragma unroll 1
    for (int l = 0; l < DEPTH; ++l) {
        {
            IDS(); GAS unsigned char* ws = FRESH_WS(); KP kp = FRESH_P(); (void)kp; const GAS bf16_t* wl = Wc + (size_t)l * LAYER_W;
            for (int i = gtid; i < MTOK; i += NT) rowssA[i] = 0ull;
            { pg8::Gemm g{XB, wl + OFF_IN, MTOK, PW, DM, DM}; pg8::StaticOrder S; S.init(MTOK, PW, G, bx);
              pg8::EpiInMain E{ws, (int)WS_ROWSSB};

#ifndef NO_G1
pg8::gemm_phase<pg8::EpiInMain, pg8::StaticOrder, true, true>(lds, g, S, E, tid);
#endif
 }
            { pg8::Gemm g{wl + OFF_IN + (size_t)2048 * 1024, XB, 1024, MTOK, DM, DM}; pg8::StaticOrder S; S.init(1024, MTOK, G, bx);
              pg8::EpiInT E{ws, (int)WS_ROWSSB};

#ifndef NO_G2
pg8::gemm_phase<pg8::EpiInT, pg8::StaticOrder, true, true>(lds, g, S, E, tid);
#endif
 }
        }
        GRID_BAR();
        {
            IDS(); GAS unsigned char* ws = FRESH_WS(); KP kp = FRESH_P(); (void)kp;
            na_phase(P, VT, ((const GAS float*)kp->rpb) + l * (8 * 15 * 31), lds, G, bx, vcu, tid, wave, lane);
            r1_phase(P, VT, KV, ((const GAS float*)kp->dfw) + l * 4, ((const GAS float*)kp->dbw) + l * 4, lds, G, vcu, tid, wave, lane);
        }
        GRID_BAR();
        { IDS(); GAS unsigned char* ws = FRESH_WS(); KP kp = FRESH_P(); (void)kp;
#ifdef PROBE_DUP
        for (int rep = 0; rep < 2; ++rep)
#endif
        for (int idx = gtid; idx < 16 * 8192; idx += NT) {
            const int bh = idx >> 13, el = idx & 8191, h = bh & 3;
            const float cdf = ex2(128.0f * log2_decay(((const GAS float*)kp->dfw)[l * 4 + h])), cdb = ex2(128.0f * log2_decay(((const GAS float*)kp->dbw)[l * 4 + h]));
            const GAS float* kf = KV + ((size_t)bh * 64) * 8192 + el; const GAS float* kb = KV + ((size_t)(1024 + bh * 64)) * 8192 + el;
            GAS bf16_t* sfp = Sst + ((size_t)bh * 64) * 8192 + el; GAS bf16_t* sbp = Sst + ((size_t)(1024 + bh * 64)) * 8192 + el;
            float st = 0.f;
#pragma unroll 32
            for (int n = 0; n < 64; ++n) { sfp[(size_t)n * 8192] = (bf16_t)(cvt_pk_bf16(st, 0.f) & 0xffffu); st = st * cdf + kf[(size_t)n * 8192]; }
            st = 0.f;
#pragma unroll 32
            for (int n = 63; n >= 0; --n) { sbp[(size_t)n * 8192] = (bf16_t)(cvt_pk_bf16(st, 0.f) & 0xffffu); st = st * cdb + kb[(size_t)n * 8192]; }
        } }
        GRID_BAR();
        { IDS(); GAS unsigned char* ws = FRESH_WS(); KP kp = FRESH_P(); (void)kp;
          r3_phase(P, VT, Sst, ((const GAS float*)kp->rgain) + l * 512, ((const GAS float*)kp->dfw) + l * 4, ((const GAS float*)kp->dbw) + l * 4, lds, G, vcu, tid, wave, lane); }
        GRID_BAR();
        { IDS(); GAS unsigned char* ws = FRESH_WS(); KP kp = FRESH_P(); (void)kp; const GAS bf16_t* wl = Wc + (size_t)l * LAYER_W; const GAS float* xin = (l == 0) ? ((const GAS float*)kp->x) : ((GAS float*)kp->out);
          pg8::Gemm g{P, wl + OFF_OUT, MTOK, DM, DM, PW}; pg8::StaticOrder S; S.init(MTOK, DM, G, bx);
          pg8::EpiRes E{ws, (int)WS_ROWSSA}; (void)xin;

#ifndef NO_G3
pg8::gemm_phase<pg8::EpiRes, pg8::StaticOrder, true, true>(lds, g, S, E, tid);
#endif
 }
        GRID_BAR();
        {
            IDS(); GAS unsigned char* ws = FRESH_WS(); KP kp = FRESH_P(); (void)kp; const GAS bf16_t* wl = Wc + (size_t)l * LAYER_W;
            for (int i = gtid; i < MTOK; i += NT) rowssB[i] = 0ull;
            pg8::Gemm g{XB, wl + OFF_UP, MTOK, FF, DM, DM}; pg8::StaticOrder S; S.init(MTOK, FF, G, bx);
            pg8::EpiUp E{ws, (int)WS_ROWSSA};

#ifndef NO_G4
pg8::gemm_phase<pg8::EpiUp, pg8::StaticOrder, true, true>(lds, g, S, E, tid);
#endif

        }
        GRID_BAR();
        { IDS(); GAS unsigned char* ws = FRESH_WS(); KP kp = FRESH_P(); (void)kp; const GAS bf16_t* wl = Wc + (size_t)l * LAYER_W;
          pg8::Gemm g{U, wl + OFF_DN, MTOK, DM, FF, FF}; pg8::StaticOrder S; S.init(MTOK, DM, G, bx);
          pg8::EpiRes E{ws, (int)WS_ROWSSB};

#ifndef NO_G3
pg8::gemm_phase<pg8::EpiRes, pg8::StaticOrder, true, true>(lds, g, S, E, tid);
#endif
 }
        GRID_BAR();
    }
    { IDS(); GAS unsigned char* ws = FRESH_WS(); KP kp = FRESH_P(); (void)kp;
    for (int m = gw; m < MTOK; m += NGW) {
        GAS f32x4* orow = (GAS f32x4*)(((GAS float*)kp->out) + (size_t)m * DM);
        const GAS u32x4* xrow = (const GAS u32x4*)(XB + (size_t)m * DM);
        const float rs = pg8::rs_from(rowssB[m]);
#pragma unroll
        for (int j = 0; j < 2; ++j) {
            const u32x4 p = xrow[lane + 64 * j];
            const f32x4 g0 = *((const GAS f32x4*)((const GAS float*)kp->nfinal) + 2 * (lane + 64 * j)), g1 = *((const GAS f32x4*)((const GAS float*)kp->nfinal) + 2 * (lane + 64 * j) + 1);
            f32x4 a, c;
            a[0] = __uint_as_float(p.x << 16); a[1] = __uint_as_float(p.x & 0xffff0000u); a[2] = __uint_as_float(p.y << 16); a[3] = __uint_as_float(p.y & 0xffff0000u);
            c[0] = __uint_as_float(p.z << 16); c[1] = __uint_as_float(p.z & 0xffff0000u); c[2] = __uint_as_float(p.w << 16); c[3] = __uint_as_float(p.w & 0xffff0000u);
            orow[2 * (lane + 64 * j)] = a * rs * g0; orow[2 * (lane + 64 * j) + 1] = c * rs * g1;
        }
    } }
}

extern "C" void kernel_launch(void* const* d_in, const int* in_sizes, int n_in, void* d_out, int out_size, void* d_ws, size_t ws_size, hipStream_t stream) {
    static int grid_blocks = 0;
    if (grid_blocks == 0) {
        if (n_in != 12 || in_sizes[0] != MTOK * DM || out_size != MTOK * DM || ws_size < WS_END) {
            fprintf(stderr, "kernel_launch: unexpected shapes: n_in %d in0 %d out %d ws %zu (need %zu)\n", n_in, n_in > 0 ? in_sizes[0] : -1, out_size, ws_size, (size_t)WS_END); grid_blocks = -1; return; }
        int dev = 0, cus = 0, per_cu = 0;
        hipGetDevice(&dev);
        hipDeviceGetAttribute(&cus, hipDeviceAttributeMultiprocessorCount, dev);
        if (hipFuncSetAttribute((const void*)fwd_megakernel, hipFuncAttributeMaxDynamicSharedMemorySize, LDS_BYTES) != hipSuccess) { fprintf(stderr, "kernel_launch: hipFuncSetAttribute failed\n"); grid_blocks = -1; return; }
        if (hipOccupancyMaxActiveBlocksPerMultiprocessor(&per_cu, (const void*)fwd_megakernel, NTHREADS, LDS_BYTES) != hipSuccess || per_cu < 1) { fprintf(stderr, "kernel_launch: occupancy query failed (%d)\n", per_cu); (void)hipGetLastError(); per_cu = 1; }
        grid_blocks = cus * per_cu;
        fprintf(stderr, "kernel_launch: cus %d per_cu %d grid %d\n", cus, per_cu, grid_blocks);
    }
    if (grid_blocks < 0) return;
    Params p{};
    p.x = (const float*)d_in[0]; p.w_in = (const float*)d_in[1]; p.w_out = (const float*)d_in[2]; p.rpb = (const float*)d_in[3];
    p.dfw = (const float*)d_in[4]; p.dbw = (const float*)d_in[5]; p.rgain = (const float*)d_in[6]; p.nmix = (const float*)d_in[7]; p.nmlp = (const float*)d_in[8];
    p.w_up = (const float*)d_in[9]; p.w_down = (const float*)d_in[10]; p.nfinal = (const float*)d_in[11];
    p.out = (float*)d_out; p.ws = (unsigned char*)d_ws;
    p.inv2pi0 = 1.0 / (2.0 * 3.14159265358979323846); p.rbase = std::pow(10000.0, -1.0 / 32.0);
    if (hipMemsetAsync((char*)d_ws + WS_BAR, 0, BAR_ZERO_BYTES, stream) != hipSuccess) { fprintf(stderr, "kernel_launch: memset failed\n"); return; }
    void* args[] = {&p};
    hipError_t e = hipLaunchCooperativeKernel((const void*)fwd_megakernel, dim3(grid_blocks), dim3(NTHREADS), args, LDS_BYTES, stream);
    if (e != hipSuccess) fprintf(stderr, "cooperative launch failed: %s (grid %d)\n", hipGetErrorString(e), grid_blocks);
}
```

```cpp
#include <hip/hip_runtime.h>
#include <hip/hip_cooperative_groups.h>
#include <cstdio>
#include <cstdint>
#include <cmath>
namespace cg = cooperative_groups;

__device__ __forceinline__ int lane_opaque() { int l; asm volatile("v_mbcnt_lo_u32_b32 %0, -1, 0\n\tv_mbcnt_hi_u32_b32 %0, -1, %0" : "=v"(l)); return l; }
__device__ __forceinline__ float shx(float v, int mask, int lane) { return __int_as_float(__builtin_amdgcn_ds_bpermute((lane ^ mask) << 2, __float_as_int(v))); }
namespace pg8 {
#define PG8_LAS __attribute__((address_space(3)))
#define PG8_GAS __attribute__((address_space(1)))
typedef unsigned short bf16_t;
typedef short bf16x8 __attribute__((ext_vector_type(8)));
typedef float f32x4 __attribute__((ext_vector_type(4)));
typedef unsigned u32x4 __attribute__((ext_vector_type(4)));
constexpr int BM = 256, BK = 64, HALF = 128, HTB = HALF * BK * 2  , STAGE_BYTES = 8 * HTB, NXCD = 8, WGM = 8;

__host__ __device__ __forceinline__ int lds_byte(int r, int c) { const int st = (r >> 4) * 2 + (c >> 5), rr = r & 15, cc = c & 31, ob = rr * 64 + cc * 2; return st * 1024 + (ob ^ (((ob >> 9) & 1) << 5)); }
__host__ __device__ __forceinline__ void stage_rc(int b, int& R, int& C) { const int st = b / 1024, sb = b % 1024, swz = sb ^ (((sb >> 9) & 1) << 5); R = (st >> 1) * 16 + swz / 64; C = (st & 1) * 32 + (swz % 64) / 2; }
__host__ __device__ __forceinline__ int perm32(int rho) { const int n = rho >> 4, i = rho & 15; return 8 * (i >> 2) + 4 * n + (i & 3); }

struct Unit { int pm, pn; };
struct Gemm { const PG8_GAS bf16_t* A; const PG8_GAS bf16_t* Bt; int M, N, K, lda; };

struct StaticOrder {
    int nM, nN, nwg, G, c;
    __host__ __device__ void init(int M, int N, int G_, int c_) { nM = M / BM; nN = N / BM; nwg = nM * nN; G = G_; c = c_; }
    __host__ __device__ bool next(int i, Unit& u) const {
        const long L = (long)i * G + c; if (L >= nwg) return false;
        int wgid = (int)L; { const int q = nwg / NXCD, r = nwg % NXCD, xcd = wgid % NXCD, off = wgid / NXCD; wgid = (xcd < r ? xcd * (q + 1) : r * (q + 1) + (xcd - r) * q) + off; }
        const int nig = WGM * nN, gid = wgid / nig, fm = gid * WGM, gsz = (nM - fm) < WGM ? (nM - fm) : WGM;
        u.pm = fm + ((wgid % nig) % gsz); u.pn = (wgid % nig) / gsz; return true;
    }
    __device__ __forceinline__ void a_ready(const Unit&) const {}
    __device__ __forceinline__ void done(const Unit&) const {}
};


__device__ __forceinline__ unsigned cvt_pk_bf16(float lo, float hi) { unsigned r; asm("v_cvt_pk_bf16_f32 %0, %1, %2" : "=v"(r) : "v"(lo), "v"(hi)); return r; }
constexpr float RMS_EPS = 1e-6f;
constexpr float SS_SCALE = 1048576.0f, SS_INV = 1.0f / (1048576.0f * 1024.0f);
typedef unsigned long long u64_t;
__device__ __forceinline__ float rs_from(u64_t v) { return __builtin_amdgcn_rsqf((float)v * SS_INV + RMS_EPS); }

struct EpiInMain {
    static constexpr bool PERM = true, AFTER_DRAIN = false;
    PG8_GAS unsigned char* wsb; int rsoff;
    __device__ __forceinline__ void operator()(const f32x4 (&acc)[2][2][4][2], const Unit& u, int wr, int wc, int fr, int fq) const {
        const int row0 = u.pm * BM + wr * 64 + fr, col0 = u.pn * BM + wc * 32 + 8 * fq;
        const bool rot = u.pn >= 6; const int d0 = 16 * (wc & 1) + 4 * fq;
        PG8_GAS bf16_t* O = (PG8_GAS bf16_t*)(wsb + ((size_t)164 << 20)); const PG8_GAS u64_t* rowss = (const PG8_GAS u64_t*)(wsb + rsoff); const PG8_GAS float* cost = (const PG8_GAS float*)(wsb + (1u << 20)); const PG8_GAS float* sint = (const PG8_GAS float*)(wsb + (2u << 20));
#pragma unroll
        for (int ai = 0; ai < 2; ++ai)
#pragma unroll
            for (int m = 0; m < 4; ++m) {
                const int row = row0 + ai * HALF + m * 16;
                const float rs = rs_from(rowss[row]);
                f32x4 cs = (f32x4){1.f, 1.f, 1.f, 1.f}, sn = (f32x4){0.f, 0.f, 0.f, 0.f};
                if (rot) { const int pos = row & 8191; cs = *(const PG8_GAS f32x4*)(cost + pos * 32 + d0); sn = *(const PG8_GAS f32x4*)(sint + pos * 32 + d0); }
                PG8_GAS bf16_t* rowp = O + (size_t)row * 2048 + col0;
#pragma unroll
                for (int bj = 0; bj < 2; ++bj) {
                    const f32x4 a = acc[ai][bj][m][0] * rs, b = acc[ai][bj][m][1] * rs;
                    const f32x4 v0 = a * cs - b * sn, v1 = a * sn + b * cs;
                    u32x4 w; w.x = cvt_pk_bf16(v0[0], v0[1]); w.y = cvt_pk_bf16(v0[2], v0[3]); w.z = cvt_pk_bf16(v1[0], v1[1]); w.w = cvt_pk_bf16(v1[2], v1[3]);
                    *(PG8_GAS u32x4*)(rowp + bj * HALF) = w; }
            }
    }
};
struct EpiInT {
    static constexpr bool PERM = true, AFTER_DRAIN = false;
    PG8_GAS unsigned char* wsb; int rsoff;
    __device__ __forceinline__ void operator()(const f32x4 (&acc)[2][2][4][2], const Unit& u, int wr, int wc, int fr, int fq) const {
        const int row0 = u.pm * BM + wr * 64 + fr, col0 = u.pn * BM + wc * 32 + 8 * fq;
        PG8_GAS bf16_t* O = (PG8_GAS bf16_t*)(wsb + ((size_t)292 << 20)); const PG8_GAS u64_t* rowss = (const PG8_GAS u64_t*)(wsb + rsoff);
        f32x4 rs[2][2];
#pragma unroll
        for (int bj = 0; bj < 2; ++bj)
#pragma unroll
            for (int n = 0; n < 2; ++n) {
#pragma unroll
                for (int e = 0; e < 4; ++e) rs[bj][n][e] = rs_from(rowss[col0 + bj * HALF + 4 * n + e]); }
#pragma unroll
        for (int ai = 0; ai < 2; ++ai)
#pragma unroll
            for (int m = 0; m < 4; ++m) {
                PG8_GAS bf16_t* rowp = O + (size_t)(row0 + ai * HALF + m * 16) * 32768 + col0;
#pragma unroll
                for (int bj = 0; bj < 2; ++bj) {
                    const f32x4 v0 = acc[ai][bj][m][0] * rs[bj][0], v1 = acc[ai][bj][m][1] * rs[bj][1];
                    u32x4 w; w.x = cvt_pk_bf16(v0[0], v0[1]); w.y = cvt_pk_bf16(v0[2], v0[3]); w.z = cvt_pk_bf16(v1[0], v1[1]); w.w = cvt_pk_bf16(v1[2], v1[3]);
                    *(PG8_GAS u32x4*)(rowp + bj * HALF) = w; }
            }
    }
};
struct EpiUp {
    static constexpr bool PERM = true, AFTER_DRAIN = false;
    PG8_GAS unsigned char* wsb; int rsoff;
    __device__ __forceinline__ void operator()(const f32x4 (&acc)[2][2][4][2], const Unit& u, int wr, int wc, int fr, int fq) const {
        const int row0 = u.pm * BM + wr * 64 + fr, col0 = u.pn * BM + wc * 32 + 8 * fq;
        PG8_GAS bf16_t* O = (PG8_GAS bf16_t*)(wsb + ((size_t)164 << 20)); const PG8_GAS u64_t* rowss = (const PG8_GAS u64_t*)(wsb + rsoff);
#pragma unroll
        for (int ai = 0; ai < 2; ++ai)
#pragma unroll
            for (int m = 0; m < 4; ++m) {
                const int row = row0 + ai * HALF + m * 16;
                const float rs = rs_from(rowss[row]);
                PG8_GAS bf16_t* rowp = O + (size_t)row * 4096 + col0;
#pragma unroll
                for (int bj = 0; bj < 2; ++bj) {
                    f32x4 v0 = acc[ai][bj][m][0] * rs, v1 = acc[ai][bj][m][1] * rs;
#pragma unroll
                    for (int e = 0; e < 4; ++e) { const float a = fmaxf(v0[e], 0.f), b = fmaxf(v1[e], 0.f); v0[e] = a * a; v1[e] = b * b; }
                    u32x4 w; w.x = cvt_pk_bf16(v0[0], v0[1]); w.y = cvt_pk_bf16(v0[2], v0[3]); w.z = cvt_pk_bf16(v1[0], v1[1]); w.w = cvt_pk_bf16(v1[2], v1[3]);
                    *(PG8_GAS u32x4*)(rowp + bj * HALF) = w; }
            }
    }
};
struct EpiRes {
    static constexpr bool PERM = true, AFTER_DRAIN = false;
    PG8_GAS unsigned char* wsb; int rsoff;
    __device__ __forceinline__ void operator()(const f32x4 (&acc)[2][2][4][2], const Unit& u, int wr, int wc, int fr, int fq) const {
        const int row0 = u.pm * BM + wr * 64 + fr, col0 = u.pn * BM + wc * 32 + 8 * fq;
        PG8_GAS bf16_t* xb = (PG8_GAS bf16_t*)(wsb + ((size_t)100 << 20)); PG8_GAS u64_t* rowss = (PG8_GAS u64_t*)(wsb + rsoff);
        const int ln = fq * 16 + fr;
#pragma unroll
        for (int ai = 0; ai < 2; ++ai) {
            u32x4 pre[2][4][2];
#pragma unroll
            for (int m = 0; m < 4; ++m)
#pragma unroll
                for (int bj = 0; bj < 2; ++bj) pre[ai][m][bj] = *(const PG8_GAS u32x4*)(xb + (size_t)(row0 + ai * HALF + m * 16) * 1024 + col0 + bj * HALF);
#pragma unroll
            for (int m = 0; m < 4; ++m) {
                const int row = row0 + ai * HALF + m * 16; const size_t off = (size_t)row * 1024 + col0;
                float ss = 0.f;
#pragma unroll
                for (int bj = 0; bj < 2; ++bj) {
                    const u32x4 p = pre[ai][m][bj];
                    f32x4 v0 = acc[ai][bj][m][0], v1 = acc[ai][bj][m][1];
                    v0[0] += __uint_as_float(p.x << 16); v0[1] += __uint_as_float(p.x & 0xffff0000u); v0[2] += __uint_as_float(p.y << 16); v0[3] += __uint_as_float(p.y & 0xffff0000u);
                    v1[0] += __uint_as_float(p.z << 16); v1[1] += __uint_as_float(p.z & 0xffff0000u); v1[2] += __uint_as_float(p.w << 16); v1[3] += __uint_as_float(p.w & 0xffff0000u);
                    u32x4 w; w.x = cvt_pk_bf16(v0[0], v0[1]); w.y = cvt_pk_bf16(v0[2], v0[3]); w.z = cvt_pk_bf16(v1[0], v1[1]); w.w = cvt_pk_bf16(v1[2], v1[3]);
                    *(PG8_GAS u32x4*)(xb + off + bj * HALF) = w;
                    ss += (v0[0] * v0[0] + v0[1] * v0[1]) + (v0[2] * v0[2] + v0[3] * v0[3]) + (v1[0] * v1[0] + v1[1] * v1[1]) + (v1[2] * v1[2] + v1[3] * v1[3]); }
                ss += shx(ss, 16, ln); ss += shx(ss, 32, ln);
                if (fq == 0) __hip_atomic_fetch_add(rowss + row, (u64_t)(ss * SS_SCALE + 0.5f), __ATOMIC_RELAXED, __HIP_MEMORY_SCOPE_AGENT);
            }
        }
    }
};

template <class Epi, class Sched, bool ALIGN_EPI = false, bool SP2 = false>
__device__ __forceinline__ void gemm_phase(PG8_LAS unsigned char* lds, const Gemm g, const Sched& S, const Epi& E, int tid_in) {
    int tid_ = tid_in; asm volatile("" : "+v"(tid_));
    const int tid = tid_, wid = __builtin_amdgcn_readfirstlane(tid >> 6), lane = tid & 63, wr = wid >> 2, wc = wid & 3, fr = lane & 15, fq = lane >> 4;
    const int K = g.K, nt = K / BK;
    unsigned voffA[2], voffB[2];
#pragma unroll
    for (int i = 0; i < 2; ++i) { int R, C; stage_rc(tid * 16 + i * 8192, R, C); const int Rb = Epi::PERM ? ((R & ~31) + perm32(R & 31)) : R;
        voffA[i] = (unsigned)(R * g.lda + C) * 2u; voffB[i] = (unsigned)(Rb * K + C) * 2u; }
    const size_t kstep = (size_t)(BK * 2);
    const size_t hstep = (size_t)HALF * K * 2;
    const size_t tstep = 2 * hstep; const size_t hstepA = (size_t)HALF * g.lda * 2, tstepA = 2 * hstepA;
    const unsigned ldsw = (unsigned)wid * 1024u;
    const int aoff = lds_byte(wr * 64 + fr, fq * 8), boff = lds_byte(wc * 32 + fr, fq * 8);
#define PG8_SA(b, h) (((b) * 2 + (h)) * HTB)
#define PG8_SB(b, h) ((4 + (b) * 2 + (h)) * HTB)
#define PG8_STAGE(bufoff, gbase, voff) do { _Pragma("unroll") for (int _i = 0; _i < 2; ++_i) \
        __builtin_amdgcn_global_load_lds((const PG8_GAS unsigned*)((const PG8_GAS char*)(gbase) + (voff)[_i]), (PG8_LAS unsigned*)(lds + (bufoff) + ldsw + _i * 8192), 16, 0, 0); } while (0)
#define PG8_LDA(dst, b, h) do { _Pragma("unroll") for (int m = 0; m < 4; ++m) _Pragma("unroll") for (int k = 0; k < 2; ++k) dst[m][k] = *(const PG8_LAS bf16x8*)(lds + PG8_SA(b, h) + aoff + m * 2048 + k * 1024); } while (0)
#define PG8_LDB(dst, b, h) do { _Pragma("unroll") for (int n = 0; n < 2; ++n) _Pragma("unroll") for (int k = 0; k < 2; ++k) dst[n][k] = *(const PG8_LAS bf16x8*)(lds + PG8_SB(b, h) + boff + n * 2048 + k * 1024); } while (0)
#define PG8_MMA(ai, bj, At, Bt) do { __builtin_amdgcn_s_setprio(1); _Pragma("unroll") for (int m = 0; m < 4; ++m) _Pragma("unroll") for (int n = 0; n < 2; ++n) _Pragma("unroll") for (int k = 0; k < 2; ++k) \
        acc[ai][bj][m][n] = __builtin_amdgcn_mfma_f32_16x16x32_bf16(Bt[n][k], At[m][k], acc[ai][bj][m][n], 0, 0, 0); __builtin_amdgcn_s_setprio(0); } while (0)
#define PG8_WAIT_V(n) asm volatile("s_waitcnt vmcnt(" #n ")" ::: "memory")
#define PG8_WAIT_L(n) asm volatile("s_waitcnt lgkmcnt(" #n ")" ::: "memory")
#define PG8_BAR __builtin_amdgcn_s_barrier()
#define PG8_SCHED __builtin_amdgcn_sched_barrier(0)
    Unit cur, nxt; int ui = 0;
    if (!S.next(0, cur)) return;
    f32x4 acc[2][2][4][2];
#pragma unroll
    for (int a = 0; a < 2; ++a)
#pragma unroll
        for (int b = 0; b < 2; ++b)
#pragma unroll
            for (int m = 0; m < 4; ++m)
#pragma unroll
                for (int n = 0; n < 2; ++n) acc[a][b][m][n] = (f32x4){0.f, 0.f, 0.f, 0.f};
    bf16x8 At[4][2], B0[2][2], B1[2][2];
    const PG8_GAS char* cA = (const PG8_GAS char*)g.A + (size_t)cur.pm * tstepA; const PG8_GAS char* cB = (const PG8_GAS char*)g.Bt + (size_t)cur.pn * tstep;
    S.a_ready(cur);
    if constexpr (SP2) {
        PG8_STAGE(PG8_SB(0, 0), cB, voffB); PG8_STAGE(PG8_SB(0, 1), cB + hstep, voffB); PG8_STAGE(PG8_SA(0, 0), cA, voffA); PG8_STAGE(PG8_SA(0, 1), cA + hstepA, voffA);
        if (wr == 1) PG8_BAR;
        PG8_WAIT_V(2); PG8_BAR;
        PG8_STAGE(PG8_SB(1, 0), cB + kstep, voffB); PG8_STAGE(PG8_SA(1, 0), cA + kstep, voffA); PG8_STAGE(PG8_SB(1, 1), cB + hstep + kstep, voffB);
        PG8_WAIT_V(6); PG8_BAR;
    } else {
        PG8_STAGE(PG8_SB(0, 0), cB, voffB); PG8_STAGE(PG8_SA(0, 0), cA, voffA); PG8_STAGE(PG8_SB(0, 1), cB + hstep, voffB); PG8_STAGE(PG8_SA(0, 1), cA + hstepA, voffA);
        if (wr == 1) PG8_BAR;
        PG8_WAIT_V(4); PG8_BAR;
        PG8_STAGE(PG8_SB(1, 0), cB + kstep, voffB); PG8_STAGE(PG8_SA(1, 0), cA + kstep, voffA); PG8_STAGE(PG8_SB(1, 1), cB + hstep + kstep, voffB);
        PG8_WAIT_V(6); PG8_BAR;
    }
    for (;;) {
        const bool has_next = S.next(ui + 1, nxt);
        const PG8_GAS char* nA = has_next ? (const PG8_GAS char*)g.A + (size_t)nxt.pm * tstepA : cA; const PG8_GAS char* nB = has_next ? (const PG8_GAS char*)g.Bt + (size_t)nxt.pn * tstep : cB;
        for (int t = 0; t < nt; t += 2) {
            const bool last = (t == nt - 2);
            const PG8_GAS char* a1 = cA + (size_t)(t + 1) * kstep;
            const PG8_GAS char* a2 = last ? nA : cA + (size_t)(t + 2) * kstep; const PG8_GAS char* b2 = last ? nB : cB + (size_t)(t + 2) * kstep;
            const PG8_GAS char* a3 = a2 + kstep; const PG8_GAS char* b3 = b2 + kstep;
            if (last && has_next) S.a_ready(nxt);
            if constexpr (SP2) {
            PG8_LDB(B0, 0, 0); PG8_LDB(B1, 0, 1); PG8_SCHED; PG8_LDA(At, 0, 0); PG8_STAGE(PG8_SA(1, 1), a1 + hstepA, voffA);
            PG8_WAIT_V(8); PG8_WAIT_L(0); PG8_BAR; PG8_MMA(0, 0, At, B0); PG8_MMA(0, 1, At, B1); PG8_BAR; PG8_SCHED;
            PG8_LDA(At, 0, 1); PG8_STAGE(PG8_SB(0, 0), b2, voffB); PG8_STAGE(PG8_SB(0, 1), b2 + hstep, voffB); PG8_STAGE(PG8_SA(0, 0), a2, voffA);
            PG8_WAIT_V(8); PG8_WAIT_L(0); PG8_BAR; PG8_MMA(1, 0, At, B0); PG8_MMA(1, 1, At, B1); PG8_BAR; PG8_SCHED;
            PG8_LDB(B0, 1, 0); PG8_LDB(B1, 1, 1); PG8_SCHED; PG8_LDA(At, 1, 0); PG8_STAGE(PG8_SA(0, 1), a2 + hstepA, voffA);
            PG8_WAIT_V(8); PG8_WAIT_L(0); PG8_BAR; PG8_MMA(0, 0, At, B0); PG8_MMA(0, 1, At, B1); PG8_BAR; PG8_SCHED;
            PG8_LDA(At, 1, 1); PG8_STAGE(PG8_SB(1, 0), b3, voffB); PG8_STAGE(PG8_SB(1, 1), b3 + hstep, voffB); PG8_STAGE(PG8_SA(1, 0), a3, voffA);
            PG8_WAIT_V(8); PG8_WAIT_L(0); PG8_BAR; PG8_MMA(1, 0, At, B0); PG8_MMA(1, 1, At, B1); PG8_BAR; PG8_SCHED;
            } else {
            PG8_LDB(B0, 0, 0); PG8_SCHED; PG8_LDA(At, 0, 0); PG8_STAGE(PG8_SA(1, 1), a1 + hstepA, voffA);
            PG8_WAIT_L(8); PG8_BAR; PG8_WAIT_L(0); PG8_MMA(0, 0, At, B0); PG8_BAR; PG8_SCHED;
            PG8_LDB(B1, 0, 1); PG8_STAGE(PG8_SB(0, 0), b2, voffB);
            PG8_BAR; PG8_WAIT_L(0); PG8_MMA(0, 1, At, B1); PG8_BAR;
            PG8_LDA(At, 0, 1); PG8_STAGE(PG8_SA(0, 0), a2, voffA);
            PG8_BAR; PG8_WAIT_L(0); PG8_MMA(1, 0, At, B0); PG8_BAR; PG8_SCHED;
            PG8_STAGE(PG8_SB(0, 1), b2 + hstep, voffB);
            PG8_WAIT_V(6); PG8_BAR; PG8_MMA(1, 1, At, B1); PG8_BAR;
            PG8_LDB(B0, 1, 0); PG8_SCHED; PG8_LDA(At, 1, 0); PG8_STAGE(PG8_SA(0, 1), a2 + hstepA, voffA);
            PG8_WAIT_L(8); PG8_BAR; PG8_WAIT_L(0); PG8_MMA(0, 0, At, B0); PG8_BAR; PG8_SCHED;
            PG8_LDB(B1, 1, 1); PG8_STAGE(PG8_SB(1, 0), b3, voffB);
            PG8_BAR; PG8_WAIT_L(0); PG8_MMA(0, 1, At, B1); PG8_BAR;
            PG8_LDA(At, 1, 1); PG8_STAGE(PG8_SA(1, 0), a3, voffA);
            PG8_BAR; PG8_WAIT_L(0); PG8_MMA(1, 0, At, B0); PG8_BAR; PG8_SCHED;
            PG8_STAGE(PG8_SB(1, 1), b3 + hstep, voffB);
            PG8_WAIT_V(6); PG8_BAR; PG8_MMA(1, 1, At, B1); PG8_BAR;
            }
        }
        if constexpr (ALIGN_EPI) { if (wr == 0) PG8_BAR; }
        if constexpr (!Epi::AFTER_DRAIN) { E(acc, cur, wr, wc, fr, fq); S.done(cur); }
        if (!has_next) break;
#pragma unroll
        for (int a = 0; a < 2; ++a)
#pragma unroll
            for (int b = 0; b < 2; ++b)
#pragma unroll
                for (int m = 0; m < 4; ++m)
#pragma unroll
                    for (int n = 0; n < 2; ++n) acc[a][b][m][n] = (f32x4){0.f, 0.f, 0.f, 0.f};
        cur = nxt; cA = nA; cB = nB; ++ui;
        if constexpr (ALIGN_EPI) { if (wr == 1) PG8_BAR; }
    }
    PG8_WAIT_V(0);
    if constexpr (!ALIGN_EPI) { if (wr == 0) PG8_BAR; }
    PG8_BAR;
    if constexpr (Epi::AFTER_DRAIN) { E.fused(acc, cur, wr, wc, fr, fq, lds, wid, lane); S.done(cur); }
#undef PG8_SA
#undef PG8_SB
#undef PG8_STAGE
#undef PG8_LDA
#undef PG8_LDB
#undef PG8_MMA
#undef PG8_WAIT_V
#undef PG8_WAIT_L
#undef PG8_BAR
#undef PG8_SCHED
}
}

#define LAS __attribute__((address_space(3)))
#define GAS __attribute__((address_space(1)))
typedef pg8::bf16_t bf16_t;
typedef pg8::bf16x8 bf16x8;
typedef pg8::f32x4 f32x4;
typedef pg8::u32x4 u32x4;
typedef unsigned u32x2 __attribute__((ext_vector_type(2)));
using pg8::cvt_pk_bf16;

constexpr int NWAVES = 8, NTHREADS = 512;
constexpr int BATCH = 4, SEQ = 8192, DM = 1024, DEPTH = 4, MTOK = BATCH * SEQ, FF = 4096;
constexpr int PW = 2048;
constexpr int PC_NAQ = 0, PC_GATE = 512, PC_NAK = 1024, PC_RQ = 1536, PC_RK = 1792;
constexpr int VT_NAV = 0, VT_RV = 512;
constexpr float LOG2E = 1.4426950408889634f;
constexpr float GN_EPS = 1e-6f;
constexpr size_t OFF_IN = 0, OFF_OUT = (size_t)3072 * 1024, OFF_UP = OFF_OUT + (size_t)1024 * 1024, OFF_DN = OFF_UP + (size_t)4096 * 1024, LAYER_W = OFF_DN + (size_t)1024 * 4096;
constexpr size_t MiB = 1u << 20;
constexpr size_t WS_BAR = 512 * 1024, BAR_ZERO_BYTES = 16 * 1024;
constexpr size_t WS_ROWSSA = 0, WS_ROWSSB = 256 * 1024, WS_COS = 1 * MiB, WS_SIN = 2 * MiB, WS_W = 4 * MiB;
constexpr size_t WS_XB = 100 * MiB;
constexpr size_t WS_P = 164 * MiB;
constexpr size_t WS_VT = 292 * MiB;
constexpr size_t WS_S = 356 * MiB;
constexpr size_t WS_U = 164 * MiB;
constexpr size_t WS_KV = 420 * MiB;
constexpr size_t WS_END = 484 * MiB;
static_assert(WS_W + DEPTH * LAYER_W * 2 <= WS_XB, "weights fit");
static_assert(WS_P == ((size_t)164 << 20) && WS_VT == ((size_t)292 << 20) && WS_U == ((size_t)164 << 20) && WS_XB == ((size_t)100 << 20) && WS_COS == (1u << 20) && WS_SIN == (2u << 20), "epilogue offsets");
constexpr int LDS_BYTES = 147456, LDSCTL_OFF = 146464, MISC_OFF = LDSCTL_OFF;

__device__ __forceinline__ f32x4 mfma16(bf16x8 a, bf16x8 b, f32x4 c) { return __builtin_amdgcn_mfma_f32_16x16x32_bf16(a, b, c, 0, 0, 0); }
__device__ __forceinline__ float wave_sum(float v, int lane) {
#pragma unroll
    for (int o = 1; o < 64; o <<= 1) v += shx(v, o, lane);
    return v;
}
__device__ __forceinline__ float bf2f(unsigned short b) { return __uint_as_float((unsigned)b << 16); }
__device__ __forceinline__ float ex2(float x) { return __builtin_amdgcn_exp2f(x); }
__device__ __forceinline__ float log2_decay(float z) { return log1pf(-expf(z)) * LOG2E; }

__device__ __forceinline__ int permq(int c) { const int h = c >> 6, p = c & 63, j = p >> 3, s = p & 7; return h * 64 + ((s < 4) ? (4 * j + s) : (32 + 4 * j + (s - 4))); }
__device__ __forceinline__ int srccol_in(int nd, float& sc) {
    sc = 1.f;
    if (nd < 512) { sc = 0.125f; return nd; }
    if (nd < 1024) return 2560 + (nd - 512);
    if (nd < 1536) return 512 + (nd - 1024);
    if (nd < 1792) return 1536 + permq(nd - 1536);
    if (nd < 2048) { sc = 0.125f; return 1792 + permq(nd - 1792); }
    if (nd < 2560) return 1024 + (nd - 2048);
    return 2048 + (nd - 2560);
}
template <int MODE>
__device__ __forceinline__ void transpose_item(const GAS float* W, int K, int N, GAS bf16_t* WT, const GAS float* gain, LAS float* scr, int item, int lane) {
    const int nblk = N / 32, kb = item / nblk, nb = item % nblk, k0 = 64 * kb, n0 = 32 * nb;
    float csc = 1.f; int sc = n0 + (lane & 31);
    if (MODE == 1) sc = srccol_in(n0 + (lane & 31), csc);
    float wv[32];
#pragma unroll
    for (int i = 0; i < 32; ++i) wv[i] = W[(size_t)(k0 + 2 * i + (lane >> 5)) * N + sc];
    float gv[32];
#pragma unroll
    for (int i = 0; i < 32; ++i) gv[i] = gain ? gain[k0 + 2 * i + (lane >> 5)] * csc : csc;
#pragma unroll
    for (int i = 0; i < 32; ++i) scr[(2 * i + (lane >> 5)) * 33 + (lane & 31)] = wv[i] * gv[i];
    asm volatile("s_waitcnt lgkmcnt(0)" ::: "memory");
    const int c = lane & 7;
#pragma unroll
    for (int j = 0; j < 4; ++j) { const int n = (lane >> 3) + 8 * j; const LAS float* s = scr + (8 * c) * 33 + n;
        u32x4 o; o.x = cvt_pk_bf16(s[0 * 33], s[1 * 33]); o.y = cvt_pk_bf16(s[2 * 33], s[3 * 33]); o.z = cvt_pk_bf16(s[4 * 33], s[5 * 33]); o.w = cvt_pk_bf16(s[6 * 33], s[7 * 33]);
        *(GAS u32x4*)(WT + (size_t)(n0 + n) * K + k0 + 8 * c) = o; }
    asm volatile("s_waitcnt lgkmcnt(0)" ::: "memory");
}

struct Params {
    const float* x; const float* w_in; const float* w_out; const float* rpb; const float* dfw; const float* dbw; const float* rgain;
    const float* nmix; const float* nmlp; const float* w_up; const float* w_down; const float* nfinal;
    float* out; unsigned char* ws; double inv2pi0; double rbase;
};

#define SCHED_FENCE() __builtin_amdgcn_sched_barrier(0)
template <bool DRY = false>
__device__ __forceinline__ void na_task(GAS bf16_t* P, const GAS bf16_t* VT, const LAS float* rpb, int b, int r, int cb, int h, int lane) {
    const int g = lane >> 4, qi = lane & 15;
    const int rs0 = min(max(r - 4, 0), 120), bs = min(max(cb * 16 - 8, 0), 32);
    const int c = cb * 16 + qi, cs = min(max(c - 8, 0), 48);
    const size_t tokq = (size_t)b * SEQ + r * 64 + c;
    GAS bf16_t* qp = P + tokq * PW + PC_NAQ + h * 64;
    const bf16x8 q0 = *(const GAS bf16x8*)(qp + 16 * g), q1 = *(const GAS bf16x8*)(qp + 16 * g + 8);
    const GAS bf16_t* kbase = P + ((size_t)b * SEQ + rs0 * 64 + bs + qi) * PW + PC_NAK + h * 64 + 16 * g;
    bf16x8 kf[16][2];
#pragma unroll
    for (int kt = 0; kt < 16; ++kt) {
        const GAS bf16_t* kp = kbase + (size_t)((kt >> 1) * 64 + (kt & 1) * 16) * PW;
        kf[kt][0] = *(const GAS bf16x8*)kp; kf[kt][1] = *(const GAS bf16x8*)(kp + 8);
    }
    SCHED_FENCE();
    f32x4 S[16];
#pragma unroll
    for (int kt = 0; kt < 16; ++kt) {
        f32x4 z = (f32x4){0.f, 0.f, 0.f, 0.f};
        z = mfma16(kf[kt][0], q0, z); S[kt] = mfma16(kf[kt][1], q1, z);
    }
    SCHED_FENCE();
    const GAS bf16_t* vbase = VT + (size_t)(VT_NAV + h * 64 + qi) * MTOK + (size_t)b * SEQ + rs0 * 64 + bs + 4 * g;
    u32x2 vf[8][4][2];
#pragma unroll
    for (int s = 0; s < 8; ++s)
#pragma unroll
        for (int dt = 0; dt < 4; ++dt) {
            const GAS bf16_t* vp = vbase + (size_t)dt * 16 * MTOK + s * 64;
            vf[s][dt][0] = *(const GAS u32x2*)vp; vf[s][dt][1] = *(const GAS u32x2*)(vp + 16);
        }
    SCHED_FENCE();
    float mx = -3.0e38f;
    const int dcb = bs - c + 15 + 4 * g, kcb = bs + 4 * g - cs;
#pragma unroll
    for (int kt = 0; kt < 16; ++kt) {
        const int dr = rs0 + (kt >> 1) - r + 7;
        const LAS float* brow = rpb + (h * 15 + dr) * 31;
#pragma unroll
        for (int i = 0; i < 4; ++i) {
            const int off = (kt & 1) * 16 + i;
            const bool valid = (unsigned)(kcb + off) < 16u;
            float bv = brow[min(max(dcb + off, 0), 30)];
            asm volatile("" : "+v"(bv));
            const float sv = valid ? __builtin_fmaf(S[kt][i], LOG2E, bv) : -1.0e30f;
            S[kt][i] = sv; mx = fmaxf(mx, sv);
        }
    }
    mx = fmaxf(mx, shx(mx, 16, lane)); mx = fmaxf(mx, shx(mx, 32, lane));
    float l = 0.f;
#pragma unroll
    for (int kt = 0; kt < 16; ++kt)
#pragma unroll
        for (int i = 0; i < 4; ++i) { const float pv = ex2(S[kt][i] - mx); S[kt][i] = pv; l += pv; }
    l += shx(l, 16, lane); l += shx(l, 32, lane);
    f32x4 O[4];
#pragma unroll
    for (int dt = 0; dt < 4; ++dt) O[dt] = (f32x4){0.f, 0.f, 0.f, 0.f};
#pragma unroll
    for (int s = 0; s < 8; ++s) {
        u32x4 pw; pw.x = cvt_pk_bf16(S[2 * s][0], S[2 * s][1]); pw.y = cvt_pk_bf16(S[2 * s][2], S[2 * s][3]);
        pw.z = cvt_pk_bf16(S[2 * s + 1][0], S[2 * s + 1][1]); pw.w = cvt_pk_bf16(S[2 * s + 1][2], S[2 * s + 1][3]);
        const bf16x8 pb = __builtin_bit_cast(bf16x8, pw);
#pragma unroll
        for (int dt = 0; dt < 4; ++dt) {
            u32x4 vw; vw.x = vf[s][dt][0].x; vw.y = vf[s][dt][0].y; vw.z = vf[s][dt][1].x; vw.w = vf[s][dt][1].y;
            O[dt] = mfma16(__builtin_bit_cast(bf16x8, vw), pb, O[dt]);
        }
    }
    const float inv = 1.0f / l;
    if (!DRY || l < 0.f)
#pragma unroll
    for (int dt = 0; dt < 4; ++dt) {
        u32x2 w; w.x = cvt_pk_bf16(O[dt][0] * inv, O[dt][1] * inv); w.y = cvt_pk_bf16(O[dt][2] * inv, O[dt][3] * inv);
        *(GAS u32x2*)(qp + dt * 16 + 4 * g) = w;
    }
}

__device__ __forceinline__ void r1_task(const GAS bf16_t* P, const GAS bf16_t* VT, GAS float* KV, int b, int n, int h, float lgf, float lgb, int wave, int lane) {
    const int g = lane >> 4, qi = lane & 15, mt = wave & 3, eh = wave >> 2;
    const size_t tok0 = (size_t)b * SEQ + n * 128;
    const GAS bf16_t* kp0 = P + (tok0 + 8 * g) * PW + PC_RK + h * 64 + mt * 16 + qi;
    const GAS bf16_t* vp0 = VT + (size_t)(VT_RV + h * 128 + eh * 64 + qi) * MTOK + tok0 + 8 * g;
    unsigned short kr[4][8]; bf16x8 Bv[4][4];
#pragma unroll
    for (int s = 0; s < 4; ++s)
#pragma unroll
        for (int i = 0; i < 8; ++i) kr[s][i] = kp0[(size_t)(32 * s + i) * PW];
#pragma unroll
    for (int s = 0; s < 4; ++s)
#pragma unroll
        for (int jn = 0; jn < 4; ++jn) Bv[s][jn] = *(const GAS bf16x8*)(vp0 + (size_t)jn * 16 * MTOK + 32 * s);
    SCHED_FENCE();
    f32x4 aF[4], aB[4];
#pragma unroll
    for (int j = 0; j < 4; ++j) { aF[j] = (f32x4){0.f, 0.f, 0.f, 0.f}; aB[j] = (f32x4){0.f, 0.f, 0.f, 0.f}; }
#pragma unroll
    for (int s = 0; s < 4; ++s) {
        u32x4 wf, wb;
        {
            float zf[8], zb[8];
#pragma unroll
            for (int i = 0; i < 8; ++i) { const int j = 32 * s + 8 * g + i; const float kf = bf2f(kr[s][i]); zf[i] = kf * ex2(lgf * (float)(127 - j)); zb[i] = kf * ex2(lgb * (float)j); }
            wf.x = cvt_pk_bf16(zf[0], zf[1]); wf.y = cvt_pk_bf16(zf[2], zf[3]); wf.z = cvt_pk_bf16(zf[4], zf[5]); wf.w = cvt_pk_bf16(zf[6], zf[7]);
            wb.x = cvt_pk_bf16(zb[0], zb[1]); wb.y = cvt_pk_bf16(zb[2], zb[3]); wb.z = cvt_pk_bf16(zb[4], zb[5]); wb.w = cvt_pk_bf16(zb[6], zb[7]);
        }
        const bf16x8 Af = __builtin_bit_cast(bf16x8, wf), Ab = __builtin_bit_cast(bf16x8, wb);
#pragma unroll
        for (int jn = 0; jn < 4; ++jn) { aF[jn] = mfma16(Af, Bv[s][jn], aF[jn]); aB[jn] = mfma16(Ab, Bv[s][jn], aB[jn]); }
    }
    const int unit = (b * 4 + h) * 64 + n;
    GAS float* kvf = KV + ((size_t)unit * 128) * 64;
    GAS float* kvb = KV + ((size_t)(1024 + unit) * 128) * 64;
#pragma unroll
    for (int jn = 0; jn < 4; ++jn) {
        const int e = (eh * 4 + jn) * 16 + qi, d = mt * 16 + 4 * g;
        *(GAS f32x4*)(kvf + e * 64 + d) = aF[jn]; *(GAS f32x4*)(kvb + e * 64 + d) = aB[jn];
    }
}

__device__ __forceinline__ bf16x8 scale_frag(bf16x8 q, float sc) {
    const u32x4 w = __builtin_bit_cast(u32x4, q); u32x4 o;
    o.x = cvt_pk_bf16(__uint_as_float(w.x << 16) * sc, __uint_as_float(w.x & 0xffff0000u) * sc); o.y = cvt_pk_bf16(__uint_as_float(w.y << 16) * sc, __uint_as_float(w.y & 0xffff0000u) * sc);
    o.z = cvt_pk_bf16(__uint_as_float(w.z << 16) * sc, __uint_as_float(w.z & 0xffff0000u) * sc); o.w = cvt_pk_bf16(__uint_as_float(w.w << 16) * sc, __uint_as_float(w.w & 0xffff0000u) * sc);
    return __builtin_bit_cast(bf16x8, o);
}
template <bool DRY = false>
__device__ __forceinline__ void r3_task(GAS bf16_t* P, const GAS bf16_t* VT, const GAS bf16_t* Sst, const GAS float* gain, int b, int n, int h, float lgf, float lgb, int wave, int lane) {
    const int g = lane >> 4, qi = lane & 15;
    const size_t tok0 = (size_t)b * SEQ + n * 128;
    const int iq = 16 * wave + qi; const size_t tokq = tok0 + iq;
    const GAS bf16_t* qp = P + tokq * PW + PC_RQ + h * 64 + 16 * g;
    const bf16x8 q0 = *(const GAS bf16x8*)qp, q1 = *(const GAS bf16x8*)(qp + 8);
    const GAS bf16_t* kbase = P + (tok0 + qi) * PW + PC_RK + h * 64 + 16 * g;
    bf16x8 kf[8][2];
#pragma unroll
    for (int jt = 0; jt < 8; ++jt) { const GAS bf16_t* kp = kbase + (size_t)(16 * jt) * PW; kf[jt][0] = *(const GAS bf16x8*)kp; kf[jt][1] = *(const GAS bf16x8*)(kp + 8); }
    const int unit = (b * 4 + h) * 64 + n;
    const GAS bf16_t* sf = Sst + ((size_t)unit * 128 + qi) * 64 + 16 * g;
    const GAS bf16_t* sb = Sst + ((size_t)(1024 + unit) * 128 + qi) * 64 + 16 * g;
    bf16x8 stf[8][2], stb[8][2];
#pragma unroll
    for (int et = 0; et < 8; ++et) { stf[et][0] = *(const GAS bf16x8*)(sf + et * 16 * 64); stf[et][1] = *(const GAS bf16x8*)(sf + et * 16 * 64 + 8); }
    SCHED_FENCE();
    f32x4 S[8];
#pragma unroll
    for (int jt = 0; jt < 8; ++jt) { f32x4 z = (f32x4){0.f, 0.f, 0.f, 0.f}; z = mfma16(kf[jt][0], q0, z); S[jt] = mfma16(kf[jt][1], q1, z); }
    SCHED_FENCE();
    const float xif = ex2(lgf * (float)(iq + 1)), xib = ex2(lgb * (float)(128 - iq));
    f32x4 O[8];
    {
        const bf16x8 qf0 = scale_frag(q0, xif), qf1 = scale_frag(q1, xif);
#pragma unroll
        for (int et = 0; et < 8; ++et) { f32x4 z = (f32x4){0.f, 0.f, 0.f, 0.f}; z = mfma16(stf[et][0], qf0, z); O[et] = mfma16(stf[et][1], qf1, z); }
    }
    SCHED_FENCE();
    const GAS bf16_t* vbase = VT + (size_t)(VT_RV + h * 128 + qi) * MTOK + tok0 + 4 * g;
    u32x2 vf[2][8][2];
#define R3_LOADV(buf, s_) do { _Pragma("unroll") for (int et = 0; et < 8; ++et) { const GAS bf16_t* vp = vbase + (size_t)et * 16 * MTOK + 32 * (s_); vf[buf][et][0] = *(const GAS u32x2*)vp; vf[buf][et][1] = *(const GAS u32x2*)(vp + 16); } } while (0)
#define R3_PV(buf, s_) do { u32x4 pw; pw.x = cvt_pk_bf16(S[2 * (s_)][0], S[2 * (s_)][1]); pw.y = cvt_pk_bf16(S[2 * (s_)][2], S[2 * (s_)][3]); \
        pw.z = cvt_pk_bf16(S[2 * (s_) + 1][0], S[2 * (s_) + 1][1]); pw.w = cvt_pk_bf16(S[2 * (s_) + 1][2], S[2 * (s_) + 1][3]); \
        const bf16x8 pb = __builtin_bit_cast(bf16x8, pw); \
        _Pragma("unroll") for (int et = 0; et < 8; ++et) { u32x4 vw; vw.x = vf[buf][et][0].x; vw.y = vf[buf][et][0].y; vw.z = vf[buf][et][1].x; vw.w = vf[buf][et][1].y; \
            O[et] = mfma16(__builtin_bit_cast(bf16x8, vw), pb, O[et]); } } while (0)
#pragma unroll
    for (int et = 0; et < 8; ++et) { stb[et][0] = *(const GAS bf16x8*)(sb + et * 16 * 64); stb[et][1] = *(const GAS bf16x8*)(sb + et * 16 * 64 + 8); }
    R3_LOADV(0, 0);
    SCHED_FENCE();
    int iqv = iq, gv = g; asm volatile("" : "+v"(iqv), "+v"(gv));
#pragma unroll
    for (int jt = 0; jt < 8; ++jt)
#pragma unroll
        for (int i = 0; i < 4; ++i) {
            const int j = 16 * jt + 4 * gv + i, diff = iqv - j;
            const float dd = diff >= 0 ? ex2(lgf * (float)diff) : ex2(lgb * (float)(-diff));
            S[jt][i] *= dd;
        }
    SCHED_FENCE();
    {
        const bf16x8 qb0 = scale_frag(q0, xib), qb1 = scale_frag(q1, xib);
#pragma unroll
        for (int et = 0; et < 8; ++et) { O[et] = mfma16(stb[et][0], qb0, O[et]); O[et] = mfma16(stb[et][1], qb1, O[et]); }
    }
    SCHED_FENCE();
    R3_LOADV(1, 1);
    GAS bf16_t* gp = P + tokq * PW + PC_GATE + h * 128 + 4 * g;
    const GAS float* gn = gain + h * 128 + 4 * g;
    u32x2 gwv[8];
#pragma unroll
    for (int et = 0; et < 8; ++et) gwv[et] = *(const GAS u32x2*)(gp + et * 16);
    SCHED_FENCE();
    R3_PV(0, 0); SCHED_FENCE();
    R3_LOADV(0, 2); SCHED_FENCE();
    R3_PV(1, 1); SCHED_FENCE();
    R3_LOADV(1, 3); SCHED_FENCE();
    R3_PV(0, 2); R3_PV(1, 3);
#undef R3_LOADV
#undef R3_PV
    float sum = 0.f;
#pragma unroll
    for (int et = 0; et < 8; ++et)
#pragma unroll
        for (int i = 0; i < 4; ++i) sum += O[et][i];
    sum += shx(sum, 16, lane); sum += shx(sum, 32, lane);
    const float mu = sum * (1.0f / 128.0f);
    float var = 0.f;
#pragma unroll
    for (int et = 0; et < 8; ++et)
#pragma unroll
        for (int i = 0; i < 4; ++i) { const float dlt = O[et][i] - mu; O[et][i] = dlt; var += dlt * dlt; }
    var += shx(var, 16, lane); var += shx(var, 32, lane);
    const float rstd = __builtin_amdgcn_rsqf(var * (1.0f / 128.0f) + GN_EPS);
    if (!DRY || rstd < 0.f)
#pragma unroll
    for (int et = 0; et < 8; ++et) {
        const u32x2 gw = gwv[et];
        const f32x4 ga = *(const GAS f32x4*)(gn + et * 16);
        float gt[4] = {__uint_as_float(gw.x << 16), __uint_as_float(gw.x & 0xffff0000u), __uint_as_float(gw.y << 16), __uint_as_float(gw.y & 0xffff0000u)};
        float o[4];
#pragma unroll
        for (int i = 0; i < 4; ++i) { const float sg = gt[i] * __builtin_amdgcn_rcpf(1.0f + ex2(-gt[i] * LOG2E)); o[i] = O[et][i] * rstd * ga[i] * sg; }
        u32x2 w; w.x = cvt_pk_bf16(o[0], o[1]); w.y = cvt_pk_bf16(o[2], o[3]);
        *(GAS u32x2*)(gp + et * 16) = w;
    }
}


constexpr int NA_KSTR = 144, NA_VSTR = 976, NA_V_OFF = 480 * NA_KSTR, NA_RPB_OFF = 131584, NA_UNITS = BATCH * 8 * 4 * 16;
static_assert(NA_V_OFF + 64 * NA_VSTR <= NA_RPB_OFF, "NA LDS map");
__device__ __forceinline__ void na_phase(GAS bf16_t* P, const GAS bf16_t* VT, const GAS float* rpb_g, LAS unsigned char* lds, int G, int bx, int vcu, int tid, int wave, int lane) {
    LAS float* rpbL = (LAS float*)(lds + NA_RPB_OFF);
    for (int i = tid; i < 8 * 15 * 31; i += NTHREADS) rpbL[i] = rpb_g[i] * LOG2E;
    const int g = lane >> 4, qi = lane & 15;
    const bool xmap = (G == 256);
    const int nun = xmap ? NA_UNITS / 256 : (NA_UNITS - bx + G - 1) / G;
#define NA_UNIT(i) (xmap ? ((vcu >> 5) * (NA_UNITS / 8) + (i) * 32 + (vcu & 31)) : (bx + (i) * G))
    u32x4 pk[8], pv[8]; bf16x8 pq0, pq1;
#define NA_PREFETCH(u_) do { const int h_ = (u_) & 7, cb_ = ((u_) >> 3) & 3, rg_ = ((u_) >> 5) & 15, b_ = (u_) >> 9; \
        const int rlo_ = min(max(rg_ * 8 - 4, 0), 113), bs_ = min(max(cb_ * 16 - 8, 0), 32); \
        const GAS bf16_t* kb_ = P + ((size_t)b_ * SEQ + rlo_ * 64 + bs_) * PW + PC_NAK + h_ * 64; \
        const GAS bf16_t* vb_ = VT + (size_t)(VT_NAV + h_ * 64) * MTOK + (size_t)b_ * SEQ + rlo_ * 64 + bs_; \
        _Pragma("unroll") for (int j = 0; j < 8; ++j) { const int c_ = tid + NTHREADS * j; if (j < 7 || c_ < 3840) { \
            const int kk_ = c_ >> 3; pk[j] = *(const GAS u32x4*)(kb_ + (size_t)((kk_ >> 5) * 64 + (kk_ & 31)) * PW + (c_ & 7) * 8); \
            pv[j] = *(const GAS u32x4*)(vb_ + (size_t)((c_ >> 2) & 63) * MTOK + (c_ >> 8) * 64 + (c_ & 3) * 8); } } \
        } while (0)
#ifndef NA_NOPF
    NA_PREFETCH(NA_UNIT(0));
#endif
    for (int it = 0; it < nun; ++it) {
        const int u = NA_UNIT(it);
#ifdef NA_NOPF
        NA_PREFETCH(u);
#endif
        __syncthreads();
#pragma unroll
        for (int j = 0; j < 8; ++j) { const int c_ = tid + NTHREADS * j; if (j < 7 || c_ < 3840) {
            *(LAS u32x4*)(lds + (c_ >> 3) * NA_KSTR + (c_ & 7) * 16) = pk[j];
            *(LAS u32x4*)(lds + NA_V_OFF + ((c_ >> 2) & 63) * NA_VSTR + (c_ >> 8) * 64 + (c_ & 3) * 16) = pv[j]; } }
        { const int h_ = u & 7, cb_ = (u >> 3) & 3, rg_ = (u >> 5) & 15, b_ = u >> 9;
          const GAS bf16_t* qp_ = P + ((size_t)b_ * SEQ + (rg_ * 8 + wave) * 64 + cb_ * 16 + qi) * PW + PC_NAQ + h_ * 64 + 16 * g;
          pq0 = *(const GAS bf16x8*)qp_; pq1 = *(const GAS bf16x8*)(qp_ + 8); }
        const bf16x8 q0 = pq0, q1 = pq1;
        __syncthreads();
#ifndef NA_NOPF
        if (it + 1 < nun) NA_PREFETCH(NA_UNIT(it + 1));
#endif
        SCHED_FENCE();
        const int h = u & 7, cb = (u >> 3) & 3, rg = (u >> 5) & 15, b = u >> 9;
        const int rlo = min(max(rg * 8 - 4, 0), 113), bs = min(max(cb * 16 - 8, 0), 32);
        const int r = rg * 8 + wave, rs0 = min(max(r - 4, 0), 120), krow0 = rs0 - rlo;
        const int c = cb * 16 + qi, cs = min(max(c - 8, 0), 48);
        f32x4 S[16];
        const LAS unsigned char* ka = lds + (krow0 * 32 + qi) * NA_KSTR + g * 32;
#pragma unroll
        for (int kt = 0; kt < 16; ++kt) {
            const LAS unsigned char* kp = ka + ((kt >> 1) * 32 + (kt & 1) * 16) * NA_KSTR;
            const bf16x8 k0 = *(const LAS bf16x8*)kp, k1 = *(const LAS bf16x8*)(kp + 16);
            f32x4 z = (f32x4){0.f, 0.f, 0.f, 0.f};
            z = mfma16(k0, q0, z); S[kt] = mfma16(k1, q1, z);
        }
        float mx = -3.0e38f;
        const int dcb = bs - c + 15 + 4 * g, kcb = bs + 4 * g - cs;
        bool v0[4]; int dci[4];
#pragma unroll
        for (int i = 0; i < 4; ++i) { v0[i] = (unsigned)(kcb + i) < 16u; dci[i] = dcb + i + (v0[i] ? 0 : 16); }
        const LAS float* brow0 = rpbL + (h * 15 + (rs0 - r + 7)) * 31;
#pragma unroll
        for (int kr = 0; kr < 8; ++kr)
#pragma unroll
            for (int i = 0; i < 4; ++i) {
                const float sv = v0[i] ? S[2 * kr][i] : S[2 * kr + 1][i];
                const float tv = __builtin_fmaf(sv, LOG2E, brow0[kr * 31 + dci[i]]);
                S[2 * kr][i] = tv; mx = fmaxf(mx, tv);
            }
        mx = fmaxf(mx, shx(mx, 16, lane)); mx = fmaxf(mx, shx(mx, 32, lane));
        float l = 0.f;
#pragma unroll
        for (int kr = 0; kr < 8; ++kr)
#pragma unroll
            for (int i = 0; i < 4; ++i) { const float pvv = ex2(S[2 * kr][i] - mx); l += pvv; S[2 * kr][i] = v0[i] ? pvv : 0.f; S[2 * kr + 1][i] = v0[i] ? 0.f : pvv; }
        l += shx(l, 16, lane); l += shx(l, 32, lane);
        f32x4 O[4];
#pragma unroll
        for (int dt = 0; dt < 4; ++dt) O[dt] = (f32x4){0.f, 0.f, 0.f, 0.f};
        const LAS unsigned char* va = lds + NA_V_OFF + qi * NA_VSTR + (krow0 * 32 + 4 * g) * 2;
#pragma unroll
        for (int s = 0; s < 8; ++s) {
            u32x4 pw; pw.x = cvt_pk_bf16(S[2 * s][0], S[2 * s][1]); pw.y = cvt_pk_bf16(S[2 * s][2], S[2 * s][3]);
            pw.z = cvt_pk_bf16(S[2 * s + 1][0], S[2 * s + 1][1]); pw.w = cvt_pk_bf16(S[2 * s + 1][2], S[2 * s + 1][3]);
            const bf16x8 pb = __builtin_bit_cast(bf16x8, pw);
#pragma unroll
            for (int dt = 0; dt < 4; ++dt) {
                const LAS unsigned char* vp = va + dt * 16 * NA_VSTR + s * 64;
                const u32x2 lo = *(const LAS u32x2*)vp, hi = *(const LAS u32x2*)(vp + 32);
                u32x4 vw; vw.x = lo.x; vw.y = lo.y; vw.z = hi.x; vw.w = hi.y;
                O[dt] = mfma16(__builtin_bit_cast(bf16x8, vw), pb, O[dt]);
            }
        }
        const float inv = 1.0f / l;
        GAS bf16_t* qp = P + ((size_t)b * SEQ + r * 64 + c) * PW + PC_NAQ + h * 64;
#pragma unroll
        for (int dt = 0; dt < 4; ++dt) {
            u32x2 w; w.x = cvt_pk_bf16(O[dt][0] * inv, O[dt][1] * inv); w.y = cvt_pk_bf16(O[dt][2] * inv, O[dt][3] * inv);
            *(GAS u32x2*)(qp + dt * 16 + 4 * g) = w;
        }
    }
#undef NA_PREFETCH
#undef NA_UNIT
}


constexpr int R3_KSTR = 144, R3_VSTR = 272, R3_K_OFF = 0, R3_V_OFF = 128 * R3_KSTR, R3_F_OFF = R3_V_OFF + 128 * R3_VSTR, R3_B_OFF = R3_F_OFF + 128 * R3_KSTR;
static_assert(R3_B_OFF + 128 * R3_KSTR <= 131072, "R3 LDS map");
__device__ __forceinline__ void r3_phase(GAS bf16_t* P, const GAS bf16_t* VT, const GAS bf16_t* Sst, const GAS float* gain, const GAS float* dfw, const GAS float* dbw, LAS unsigned char* lds, int G, int vcu, int tid, int wave, int lane) {
    const int g = lane >> 4, qi = lane & 15;
    for (int u = vcu; u < 1024; u += G) {
        const int bh = u >> 6, n = u & 63, b = bh >> 2, h = bh & 3;
        const float lgf = log2_decay(dfw[h]), lgb = log2_decay(dbw[h]);
        const size_t tok0 = (size_t)b * SEQ + n * 128;
        const int iq = 16 * wave + qi; const size_t tokq = tok0 + iq;
        u32x4 sk[2], sv[4], sf2[2], sb2[2];
#pragma unroll
        for (int j = 0; j < 2; ++j) { const int c = tid + NTHREADS * j; sk[j] = *(const GAS u32x4*)(P + (tok0 + (c >> 3)) * PW + PC_RK + h * 64 + (c & 7) * 8); }
#pragma unroll
        for (int j = 0; j < 4; ++j) { const int c = tid + NTHREADS * j; sv[j] = *(const GAS u32x4*)(VT + (size_t)(VT_RV + h * 128 + (c >> 4)) * MTOK + tok0 + (c & 15) * 8); }
#pragma unroll
        for (int j = 0; j < 2; ++j) { const int c = tid + NTHREADS * j; sf2[j] = *(const GAS u32x4*)(Sst + (size_t)u * 8192 + (size_t)c * 8); sb2[j] = *(const GAS u32x4*)(Sst + (size_t)(1024 + u) * 8192 + (size_t)c * 8); }
        const GAS bf16_t* qp = P + tokq * PW + PC_RQ + h * 64 + 16 * g;
        const bf16x8 q0 = *(const GAS bf16x8*)qp, q1 = *(const GAS bf16x8*)(qp + 8);
        GAS bf16_t* gp = P + tokq * PW + PC_GATE + h * 128 + 4 * g;
        const GAS float* gn = gain + h * 128 + 4 * g;
        u32x2 gwv[8];
#pragma unroll
        for (int et = 0; et < 8; ++et) gwv[et] = *(const GAS u32x2*)(gp + et * 16);
        __syncthreads();
#pragma unroll
        for (int j = 0; j < 2; ++j) { const int c = tid + NTHREADS * j; *(LAS u32x4*)(lds + R3_K_OFF + (c >> 3) * R3_KSTR + (c & 7) * 16) = sk[j];
            *(LAS u32x4*)(lds + R3_F_OFF + (c >> 3) * R3_KSTR + (c & 7) * 16) = sf2[j]; *(LAS u32x4*)(lds + R3_B_OFF + (c >> 3) * R3_KSTR + (c & 7) * 16) = sb2[j]; }
#pragma unroll
        for (int j = 0; j < 4; ++j) { const int c = tid + NTHREADS * j; *(LAS u32x4*)(lds + R3_V_OFF + (c >> 4) * R3_VSTR + (c & 15) * 16) = sv[j]; }
        __syncthreads();
        f32x4 S[8];
#pragma unroll
        for (int jt = 0; jt < 8; ++jt) {
            const LAS unsigned char* kp = lds + R3_K_OFF + (16 * jt + qi) * R3_KSTR + g * 32;
            const bf16x8 k0 = *(const LAS bf16x8*)kp, k1 = *(const LAS bf16x8*)(kp + 16);
            f32x4 z = (f32x4){0.f, 0.f, 0.f, 0.f}; z = mfma16(k0, q0, z); S[jt] = mfma16(k1, q1, z);
        }
        int iqv = iq, gv = g; asm volatile("" : "+v"(iqv), "+v"(gv));
#pragma unroll
        for (int jt = 0; jt < 8; ++jt)
#pragma unroll
            for (int i = 0; i < 4; ++i) {
                const int j = 16 * jt + 4 * gv + i, diff = iqv - j;
                const float dd = diff >= 0 ? ex2(lgf * (float)diff) : ex2(lgb * (float)(-diff));
                S[jt][i] *= dd;
            }
        const float xif = ex2(lgf * (float)(iq + 1)), xib = ex2(lgb * (float)(128 - iq));
        const bf16x8 qf0 = scale_frag(q0, xif), qf1 = scale_frag(q1, xif), qb0 = scale_frag(q0, xib), qb1 = scale_frag(q1, xib);
        f32x4 O[8];
#pragma unroll
        for (int et = 0; et < 8; ++et) {
            const LAS unsigned char* fp = lds + R3_F_OFF + (et * 16 + qi) * R3_KSTR + g * 32;
            const LAS unsigned char* bp = lds + R3_B_OFF + (et * 16 + qi) * R3_KSTR + g * 32;
            f32x4 z = (f32x4){0.f, 0.f, 0.f, 0.f};
            z = mfma16(*(const LAS bf16x8*)fp, qf0, z); z = mfma16(*(const LAS bf16x8*)(fp + 16), qf1, z);
            z = mfma16(*(const LAS bf16x8*)bp, qb0, z); O[et] = mfma16(*(const LAS bf16x8*)(bp + 16), qb1, z);
        }
#pragma unroll
        for (int s = 0; s < 4; ++s) {
            u32x4 pw; pw.x = cvt_pk_bf16(S[2 * s][0], S[2 * s][1]); pw.y = cvt_pk_bf16(S[2 * s][2], S[2 * s][3]);
            pw.z = cvt_pk_bf16(S[2 * s + 1][0], S[2 * s + 1][1]); pw.w = cvt_pk_bf16(S[2 * s + 1][2], S[2 * s + 1][3]);
            const bf16x8 pb = __builtin_bit_cast(bf16x8, pw);
#pragma unroll
            for (int et = 0; et < 8; ++et) {
                const LAS unsigned char* vp = lds + R3_V_OFF + (et * 16 + qi) * R3_VSTR + (32 * s + 4 * g) * 2;
                const u32x2 lo = *(const LAS u32x2*)vp, hi = *(const LAS u32x2*)(vp + 32);
                u32x4 vw; vw.x = lo.x; vw.y = lo.y; vw.z = hi.x; vw.w = hi.y;
                O[et] = mfma16(__builtin_bit_cast(bf16x8, vw), pb, O[et]);
            }
        }
        float sum = 0.f;
#pragma unroll
        for (int et = 0; et < 8; ++et)
#pragma unroll
            for (int i = 0; i < 4; ++i) sum += O[et][i];
        sum += shx(sum, 16, lane); sum += shx(sum, 32, lane);
        const float mu = sum * (1.0f / 128.0f);
        float var = 0.f;
#pragma unroll
        for (int et = 0; et < 8; ++et)
#pragma unroll
            for (int i = 0; i < 4; ++i) { const float dlt = O[et][i] - mu; O[et][i] = dlt; var += dlt * dlt; }
        var += shx(var, 16, lane); var += shx(var, 32, lane);
        const float rstd = __builtin_amdgcn_rsqf(var * (1.0f / 128.0f) + GN_EPS);
#pragma unroll
        for (int et = 0; et < 8; ++et) {
            const u32x2 gw = gwv[et];
            const f32x4 ga = *(const GAS f32x4*)(gn + et * 16);
            float gt[4] = {__uint_as_float(gw.x << 16), __uint_as_float(gw.x & 0xffff0000u), __uint_as_float(gw.y << 16), __uint_as_float(gw.y & 0xffff0000u)};
            float o[4];
#pragma unroll
            for (int i = 0; i < 4; ++i) { const float sg = gt[i] * __builtin_amdgcn_rcpf(1.0f + ex2(-gt[i] * LOG2E)); o[i] = O[et][i] * rstd * ga[i] * sg; }
            u32x2 w; w.x = cvt_pk_bf16(o[0], o[1]); w.y = cvt_pk_bf16(o[2], o[3]);
            *(GAS u32x2*)(gp + et * 16) = w;
        }
    }
}


__device__ __forceinline__ void r1_phase(const GAS bf16_t* P, const GAS bf16_t* VT, GAS float* KV, const GAS float* dfw, const GAS float* dbw, LAS unsigned char* lds, int G, int vcu, int tid, int wave, int lane) {
    const int g = lane >> 4, qi = lane & 15, mt = wave & 3, eh = wave >> 2;
    for (int u = vcu; u < 1024; u += G) {
        const int bh = u >> 6, n = u & 63, b = bh >> 2, h = bh & 3;
        const float lgf = log2_decay(dfw[h]), lgb = log2_decay(dbw[h]);
        const size_t tok0 = (size_t)b * SEQ + n * 128;
        u32x4 sk[2], sv[4];
#pragma unroll
        for (int j = 0; j < 2; ++j) { const int c = tid + NTHREADS * j; sk[j] = *(const GAS u32x4*)(P + (tok0 + (c >> 3)) * PW + PC_RK + h * 64 + (c & 7) * 8); }
#pragma unroll
        for (int j = 0; j < 4; ++j) { const int c = tid + NTHREADS * j; sv[j] = *(const GAS u32x4*)(VT + (size_t)(VT_RV + h * 128 + (c >> 4)) * MTOK + tok0 + (c & 15) * 8); }
        __syncthreads();
#pragma unroll
        for (int j = 0; j < 2; ++j) { const int c = tid + NTHREADS * j; *(LAS u32x4*)(lds + R3_K_OFF + (c >> 3) * R3_KSTR + (c & 7) * 16) = sk[j]; }
#pragma unroll
        for (int j = 0; j < 4; ++j) { const int c = tid + NTHREADS * j; *(LAS u32x4*)(lds + R3_V_OFF + (c >> 4) * R3_VSTR + (c & 15) * 16) = sv[j]; }
        __syncthreads();
        f32x4 aF[4], aB[4];
#pragma unroll
        for (int j = 0; j < 4; ++j) { aF[j] = (f32x4){0.f, 0.f, 0.f, 0.f}; aB[j] = (f32x4){0.f, 0.f, 0.f, 0.f}; }
        int gv = g; asm volatile("" : "+v"(gv));
#pragma unroll
        for (int s = 0; s < 4; ++s) {
            float zf[8], zb[8];
            const LAS unsigned char* kp = lds + R3_K_OFF + (32 * s + 8 * gv) * R3_KSTR + (mt * 16 + qi) * 2;
#pragma unroll
            for (int i = 0; i < 8; ++i) { const int j = 32 * s + 8 * gv + i; const float kf = bf2f(*(const LAS unsigned short*)(kp + i * R3_KSTR)); zf[i] = kf * ex2(lgf * (float)(127 - j)); zb[i] = kf * ex2(lgb * (float)j); }
            u32x4 wf, wb;
            wf.x = cvt_pk_bf16(zf[0], zf[1]); wf.y = cvt_pk_bf16(zf[2], zf[3]); wf.z = cvt_pk_bf16(zf[4], zf[5]); wf.w = cvt_pk_bf16(zf[6], zf[7]);
            wb.x = cvt_pk_bf16(zb[0], zb[1]); wb.y = cvt_pk_bf16(zb[2], zb[3]); wb.z = cvt_pk_bf16(zb[4], zb[5]); wb.w = cvt_pk_bf16(zb[6], zb[7]);
            const bf16x8 Af = __builtin_bit_cast(bf16x8, wf), Ab = __builtin_bit_cast(bf16x8, wb);
#pragma unroll
            for (int jn = 0; jn < 4; ++jn) {
                const bf16x8 Bv = *(const LAS bf16x8*)(lds + R3_V_OFF + ((eh * 4 + jn) * 16 + qi) * R3_VSTR + (32 * s + 8 * g) * 2);
                aF[jn] = mfma16(Af, Bv, aF[jn]); aB[jn] = mfma16(Ab, Bv, aB[jn]);
            }
        }
        GAS float* kvf = KV + ((size_t)u * 128) * 64;
        GAS float* kvb = KV + ((size_t)(1024 + u) * 128) * 64;
#pragma unroll
        for (int jn = 0; jn < 4; ++jn) {
            const int e = (eh * 4 + jn) * 16 + qi, d = mt * 16 + 4 * g;
            *(GAS f32x4*)(kvf + e * 64 + d) = aF[jn]; *(GAS f32x4*)(kvb + e * 64 + d) = aB[jn];
        }
    }
}

#define RLX_AGENT __ATOMIC_RELAXED, __HIP_MEMORY_SCOPE_AGENT
#define XB_TMO      128
#define XB_XCNT(j)  (256  + 64 * (j))
#define XB_XSUB(j)  (1280 + 64 * (j))
#define XB_XGEN(j)  (2304 + 64 * (j))
#define XB_TOP      3328
#define XB_TOPGEN   3392
#define XCD_BAR_WORDS 3456
#define XB_SPIN_CAP (1u << 18)

__device__ __forceinline__ unsigned xb_ld(unsigned* p)              { return __hip_atomic_load(p, __ATOMIC_RELAXED, __HIP_MEMORY_SCOPE_AGENT); }
__device__ __forceinline__ unsigned xb_add(unsigned* p, unsigned v) { return __hip_atomic_fetch_add(p, v, __ATOMIC_RELAXED, __HIP_MEMORY_SCOPE_AGENT); }
__device__ __forceinline__ unsigned xb_xcc_id() { return (unsigned)__builtin_amdgcn_s_getreg((3 << 11) | 20) & 0xFu; }
#define XB_SPIN(cond, bar) do { unsigned _sp = 0; while (cond) { __builtin_amdgcn_s_sleep(1); \
    if ((++_sp & 255u) == 0u) { if (xb_ld(&(bar)[XB_TMO])) break; if (_sp > XB_SPIN_CAP) { atomicAdd(&(bar)[XB_TMO], 1u); break; } } } } while (0)

struct XcdBarrier {
    bool t0;
    unsigned* bar; unsigned x;
    volatile LAS unsigned* st;
};

__device__ __forceinline__ XcdBarrier xcd_barrier_post(unsigned* bar, volatile LAS unsigned* st) {
    XcdBarrier b; b.bar = bar; b.x = xb_xcc_id(); b.st = st; b.t0 = (threadIdx.x == 0);
    if (threadIdx.x == 0) (void)xb_add(&bar[XB_XCNT(b.x)], 1u);
    return b;
}
__device__ __forceinline__ void xcd_barrier_complete(unsigned* bar, unsigned x, unsigned& nloc, unsigned& nx) {
    const unsigned G = gridDim.x * gridDim.y * gridDim.z;
    unsigned sum, cnt, mine, sp = 0u;
    for (;;) {
        sum = 0u; cnt = 0u; mine = 0u;
#pragma unroll
        for (unsigned j = 0; j < 16; ++j) { const unsigned c = xb_ld(&bar[XB_XCNT(j)]); sum += c; cnt += (c > 0u) ? 1u : 0u; mine = (j == x) ? c : mine; }
        if (sum == G) break;
        __builtin_amdgcn_s_sleep(1);
        if ((++sp & 255u) == 0u) { if (xb_ld(&bar[XB_TMO])) break; if (sp > XB_SPIN_CAP) { atomicAdd(&bar[XB_TMO], 1u); break; } }
    }
    nloc = mine > 0u ? mine : 1u; nx = cnt > 0u ? cnt : 1u;
}

__device__ __forceinline__ void xcd_barrier(const XcdBarrier& b) {
    asm volatile("s_waitcnt vmcnt(0)" ::: "memory");
    __syncthreads();
    if (b.t0) {
        unsigned* bar = b.bar;
        __builtin_amdgcn_s_waitcnt(0);
        unsigned nloc = b.st[0], nx = b.st[1];
        if (nloc == 0u) { xcd_barrier_complete(bar, b.x, nloc, nx); b.st[0] = nloc; b.st[1] = nx; }
        const unsigned old = xb_add(&bar[XB_XSUB(b.x)], 1u);
        const unsigned gen = old / nloc;
        if (old + 1u == (gen + 1u) * nloc) {
            __builtin_amdgcn_fence(__ATOMIC_RELEASE, "agent");
            asm volatile("s_waitcnt vmcnt(0)" ::: "memory");
            const unsigned og = xb_add(&bar[XB_TOP], 1u);
            const unsigned tg = og / nx;
            if (og + 1u == (tg + 1u) * nx) xb_add(&bar[XB_TOPGEN], 1u);
            else XB_SPIN(xb_ld(&bar[XB_TOPGEN]) == tg, bar);
            __builtin_amdgcn_fence(__ATOMIC_ACQUIRE, "agent");
            xb_add(&bar[XB_XGEN(b.x)], 1u);
            asm volatile("s_waitcnt vmcnt(0)" ::: "memory");
        } else {
            XB_SPIN(xb_ld(&bar[XB_XGEN(b.x)]) == gen, bar);
            __builtin_amdgcn_fence(__ATOMIC_ACQUIRE, "agent");
            asm volatile("s_waitcnt vmcnt(0)" ::: "memory");
        }
    }
    __syncthreads();
}

__global__ void __launch_bounds__(NTHREADS, 2) fwd_megakernel(Params p) {
    extern __shared__ __attribute__((aligned(16))) unsigned char lds_raw[];
    LAS unsigned char* lds = (LAS unsigned char*)lds_raw;
typedef const __attribute__((address_space(4))) Params* KP;
#define FRESH_P() ({ KP _q = (KP)__builtin_amdgcn_kernarg_segment_ptr(); asm volatile("" : "+s"(_q)); _q; })
#define FRESH_WS() ({ KP _q = FRESH_P(); unsigned char* _w = _q->ws; asm volatile("" : "+s"(_w)); (GAS unsigned char*)_w; })
    cg::grid_group grid = cg::this_grid();
    const int wave0 = __builtin_amdgcn_readfirstlane(threadIdx.x >> 6);
    for (int u = threadIdx.x; u < (LDS_BYTES - LDSCTL_OFF) / 4; u += NTHREADS) ((LAS unsigned*)(lds + LDSCTL_OFF))[u] = 0u;
    static_assert(LDSCTL_OFF >= 131584 + 8 * 15 * 31 * 4 && MISC_OFF + 32 + 8 <= LDS_BYTES, "LDS map");
    __syncthreads();
    { KP q0 = FRESH_P(); (void)xcd_barrier_post((unsigned*)(q0->ws + WS_BAR), (volatile LAS unsigned*)(lds + MISC_OFF + 32)); }
#define GRID_BAR() do { XcdBarrier _b; _b.t0 = (wave0 == 0) && (lane_opaque() == 0); _b.bar = (unsigned*)(FRESH_WS() + WS_BAR); _b.x = xb_xcc_id(); _b.st = (volatile LAS unsigned*)(lds + MISC_OFF + 32); xcd_barrier(_b); } while (0)
#define IDS() int w0_ = wave0; asm volatile("" : "+s"(w0_)); int tid = w0_ * 64 + lane_opaque(); int G = gridDim.x; asm volatile("" : "+s"(G)); \
    const int lane = tid & 63, wave = __builtin_amdgcn_readfirstlane(tid >> 6), bx = blockIdx.x; \
    const int vcu = (G % 8 == 0) ? (bx % 8) * (G / 8) + bx / 8 : bx;   \
    const int gw = vcu * NWAVES + wave, NGW = G * NWAVES, gtid = bx * NTHREADS + tid, NT = G * NTHREADS; \
    (void)lane; (void)wave; (void)vcu; (void)gw; (void)NGW; (void)gtid; (void)NT;
#define rowssA ((GAS unsigned long long*)(ws + WS_ROWSSA))
#define rowssB ((GAS unsigned long long*)(ws + WS_ROWSSB))
#define cost ((GAS float*)(ws + WS_COS))
#define sint ((GAS float*)(ws + WS_SIN))
#define Wc ((GAS bf16_t*)(ws + WS_W))
#define XB ((GAS bf16_t*)(ws + WS_XB))
#define KV ((GAS float*)(ws + WS_KV))
#define P ((GAS bf16_t*)(ws + WS_P))
#define VT ((GAS bf16_t*)(ws + WS_VT))
#define Sst ((GAS bf16_t*)(ws + WS_S))
#define U ((GAS bf16_t*)(ws + WS_U))

    {
        IDS(); GAS unsigned char* ws = FRESH_WS(); KP kp = FRESH_P(); (void)kp;
        LAS float* scr = (LAS float*)(lds + wave * 16384);
        constexpr int I_IN = 16 * 96, I_OUT = 16 * 32, I_UP = 16 * 128, I_DN = 64 * 32, I_L = I_IN + I_OUT + I_UP + I_DN;
#define WI_DECODE(it_, SRC, GN, DST, NN, KK, CS) do { const int l_ = (it_) / I_L; int r_ = (it_) % I_L; GAS bf16_t* wl_ = Wc + (size_t)l_ * LAYER_W; const GAS float* W_; GAS bf16_t* T_; int mode_ = 0; \
            if (r_ < I_IN) { W_ = ((const GAS float*)kp->w_in) + (size_t)l_ * 1024 * 3072; NN = 3072; KK = 1024; T_ = wl_ + OFF_IN; GN = ((const GAS float*)kp->nmix) + l_ * 1024; mode_ = 1; } \
            else if ((r_ -= I_IN) < I_OUT) { W_ = ((const GAS float*)kp->w_out) + (size_t)l_ * 1024 * 1024; NN = 1024; KK = 1024; T_ = wl_ + OFF_OUT; GN = nullptr; } \
            else if ((r_ -= I_OUT) < I_UP) { W_ = ((const GAS float*)kp->w_up) + (size_t)l_ * 1024 * 4096; NN = 4096; KK = 1024; T_ = wl_ + OFF_UP; GN = ((const GAS float*)kp->nmlp) + l_ * 1024; } \
            else { r_ -= I_UP; W_ = ((const GAS float*)kp->w_down) + (size_t)l_ * 4096 * 1024; NN = 1024; KK = 4096; T_ = wl_ + OFF_DN; GN = nullptr; } \
            const int nblk_ = NN / 32, k0_ = 64 * (r_ / nblk_), n0_ = 32 * (r_ % nblk_); CS = 1.f; int sc_ = n0_ + (lane & 31); if (mode_) sc_ = srccol_in(n0_ + (lane & 31), CS); \
            SRC = W_ + (size_t)(k0_ + (lane >> 5)) * NN + sc_; if (GN) GN += k0_ + (lane >> 5); DST = T_ + (size_t)(n0_ + (lane >> 3)) * KK + k0_ + 8 * (lane & 7); } while (0)
        {
            const int total = DEPTH * I_L;
            const GAS float* srcA = nullptr; const GAS float* gnA = nullptr; GAS bf16_t* dstA = nullptr; int nA_ = 0, kA_ = 0; float csA = 1.f;
            float wv[32];
            int it = gw;
            if (it < total) { WI_DECODE(it, srcA, gnA, dstA, nA_, kA_, csA);
#pragma unroll
                for (int i = 0; i < 32; ++i) wv[i] = srcA[(size_t)(2 * i) * nA_]; }
            while (it < total) {
                const int nx = it + NGW;
                const GAS float* srcB = nullptr; const GAS float* gnB = nullptr; GAS bf16_t* dstB = nullptr; int nB_ = 0, kB_ = 0; float csB = 1.f;
                float wn[32];
                if (nx < total) { WI_DECODE(nx, srcB, gnB, dstB, nB_, kB_, csB);
#pragma unroll
                    for (int i = 0; i < 32; ++i) wn[i] = srcB[(size_t)(2 * i) * nB_]; }
#pragma unroll
                for (int i = 0; i < 32; ++i) { const float gq = gnA ? gnA[2 * i] * csA : csA; scr[(2 * i + (lane >> 5)) * 33 + (lane & 31)] = wv[i] * gq; }
                asm volatile("s_waitcnt lgkmcnt(0)" ::: "memory");
                { const int c = lane & 7;
#pragma unroll
                  for (int j = 0; j < 4; ++j) { const int n = (lane >> 3) + 8 * j; const LAS float* sp = scr + (8 * c) * 33 + n;
                    u32x4 o; o.x = cvt_pk_bf16(sp[0 * 33], sp[1 * 33]); o.y = cvt_pk_bf16(sp[2 * 33], sp[3 * 33]); o.z = cvt_pk_bf16(sp[4 * 33], sp[5 * 33]); o.w = cvt_pk_bf16(sp[6 * 33], sp[7 * 33]);
                    *(GAS u32x4*)(dstA + (size_t)(8 * j) * kA_) = o; } }
                asm volatile("s_waitcnt lgkmcnt(0)" ::: "memory");
                if (nx < total) {
#pragma unroll
                    for (int i = 0; i < 32; ++i) wv[i] = wn[i];
                    srcA = srcB; gnA = gnB; dstA = dstB; nA_ = nB_; kA_ = kB_; csA = csB; }
                it = nx;
            }
        }
#undef WI_DECODE
        for (int m = gw; m < MTOK; m += 2 * NGW) {
            const int m2 = m + NGW; const bool has2 = m2 < MTOK;
            const GAS f32x4* xr = (const GAS f32x4*)(((const GAS float*)kp->x) + (size_t)m * DM) + lane;
            const GAS f32x4* xr2 = (const GAS f32x4*)(((const GAS float*)kp->x) + (size_t)(has2 ? m2 : m) * DM) + lane;
            f32x4 v[4], v2[4]; float s = 0.f, s2 = 0.f;
#pragma unroll
            for (int j = 0; j < 4; ++j) { v[j] = xr[64 * j]; v2[j] = xr2[64 * j]; }
#pragma unroll
            for (int j = 0; j < 4; ++j) { s += (v[j][0] * v[j][0] + v[j][1] * v[j][1]) + (v[j][2] * v[j][2] + v[j][3] * v[j][3]); s2 += (v2[j][0] * v2[j][0] + v2[j][1] * v2[j][1]) + (v2[j][2] * v2[j][2] + v2[j][3] * v2[j][3]); }
            s = wave_sum(s, lane); s2 = wave_sum(s2, lane);
            if (lane == 0) { rowssB[m] = (unsigned long long)(s * pg8::SS_SCALE + 0.5f); if (has2) rowssB[m2] = (unsigned long long)(s2 * pg8::SS_SCALE + 0.5f); }
            GAS u32x2* o8 = (GAS u32x2*)(XB + (size_t)m * DM) + lane;
#pragma unroll
            for (int j = 0; j < 4; ++j) { u32x2 w; w.x = cvt_pk_bf16(v[j][0], v[j][1]); w.y = cvt_pk_bf16(v[j][2], v[j][3]); o8[64 * j] = w; }
            if (has2) { GAS u32x2* o82 = (GAS u32x2*)(XB + (size_t)m2 * DM) + lane;
#pragma unroll
                for (int j = 0; j < 4; ++j) { u32x2 w; w.x = cvt_pk_bf16(v2[j][0], v2[j][1]); w.y = cvt_pk_bf16(v2[j][2], v2[j][3]); o82[64 * j] = w; } }
        }
        for (int idx = gtid; idx < SEQ * 32; idx += NT) {
            const int pos = idx >> 5, i = idx & 31;
            double f = kp->inv2pi0; for (int k = 0; k < i; ++k) f *= kp->rbase;
            double a = (double)pos * f; a -= floor(a);
            const float fr = (float)a;
            cost[idx] = __builtin_amdgcn_cosf(fr); sint[idx] = __builtin_amdgcn_sinf(fr);
        }
    }
    if (gridDim.x == 0u) grid.sync();
    GRID_BAR();

#pragma unroll 1
    for (int l = 0; l < DEPTH; ++l) {
        {
            IDS(); GAS unsigned char* ws = FRESH_WS(); KP kp = FRESH_P(); (void)kp; const GAS bf16_t* wl = Wc + (size_t)l * LAYER_W;
            for (int i = gtid; i < MTOK; i += NT) rowssA[i] = 0ull;
            { pg8::Gemm g{XB, wl + OFF_IN, MTOK, PW, DM, DM}; pg8::StaticOrder S; S.init(MTOK, PW, G, bx);
              pg8::EpiInMain E{ws, (int)WS_ROWSSB};

#ifndef NO_G1
pg8::gemm_phase<pg8::EpiInMain, pg8::StaticOrder, true, true>(lds, g, S, E, tid);
#endif
 }
            { pg8::Gemm g{wl + OFF_IN + (size_t)2048 * 1024, XB, 1024, MTOK, DM, DM}; pg8::StaticOrder S; S.init(1024, MTOK, G, bx);
              pg8::EpiInT E{ws, (int)WS_ROWSSB};

#ifndef NO_G2
pg8::gemm_phase<pg8::EpiInT, pg8::StaticOrder, true, true>(lds, g, S, E, tid);
#endif
 }
        }
        GRID_BAR();
        {
            IDS(); GAS unsigned char* ws = FRESH_WS(); KP kp = FRESH_P(); (void)kp;
            na_phase(P, VT, ((const GAS float*)kp->rpb) + l * (8 * 15 * 31), lds, G, bx, vcu, tid, wave, lane);
            r1_phase(P, VT, KV, ((const GAS float*)kp->dfw) + l * 4, ((const GAS float*)kp->dbw) + l * 4, lds, G, vcu, tid, wave, lane);
        }
        GRID_BAR();
        { IDS(); GAS unsigned char* ws = FRESH_WS(); KP kp = FRESH_P(); (void)kp;
#ifdef PROBE_DUP
        for (int rep = 0; rep < 2; ++rep)
#endif
        for (int idx = gtid; idx < 16 * 8192; idx += NT) {
            const int bh = idx >> 13, el = idx & 8191, h = bh & 3;
            const float cdf = ex2(128.0f * log2_decay(((const GAS float*)kp->dfw)[l * 4 + h])), cdb = ex2(128.0f * log2_decay(((const GAS float*)kp->dbw)[l * 4 + h]));
            const GAS float* kf = KV + ((size_t)bh * 64) * 8192 + el; const GAS float* kb = KV + ((size_t)(1024 + bh * 64)) * 8192 + el;
            GAS bf16_t* sfp = Sst + ((size_t)bh * 64) * 8192 + el; GAS bf16_t* sbp = Sst + ((size_t)(1024 + bh * 64)) * 8192 + el;
            float st = 0.f;
#pragma unroll 32
            for (int n = 0; n < 64; ++n) { sfp[(size_t)n * 8192] = (bf16_t)(cvt_pk_bf16(st, 0.f) & 0xffffu); st = st * cdf + kf[(size_t)n * 8192]; }
            st = 0.f;
#pragma unroll 32
            for (int n = 63; n >= 0; --n) { sbp[(size_t)n * 8192] = (bf16_t)(cvt_pk_bf16(st, 0.f) & 0xffffu); st = st * cdb + kb[(size_t)n * 8192]; }
        } }
        GRID_BAR();
        { IDS(); GAS unsigned char* ws = FRESH_WS(); KP kp = FRESH_P(); (void)kp;
          r3_phase(P, VT, Sst, ((const GAS float*)kp->rgain) + l * 512, ((const GAS float*)kp->dfw) + l * 4, ((const GAS float*)kp->dbw) + l * 4, lds, G, vcu, tid, wave, lane); }
        GRID_BAR();
        { IDS(); GAS unsigned char* ws = FRESH_WS(); KP kp = FRESH_P(); (void)kp; const GAS bf16_t* wl = Wc + (size_t)l * LAYER_W; const GAS float* xin = (l == 0) ? ((const GAS float*)kp->x) : ((GAS float*)kp->out);
          pg8::Gemm g{P, wl + OFF_OUT, MTOK, DM, DM, PW}; pg8::StaticOrder S; S.init(MTOK, DM, G, bx);
          pg8::EpiRes E{ws, (int)WS_ROWSSA}; (void)xin;

#ifndef NO_G3
pg8::gemm_phase<pg8::EpiRes, pg8::StaticOrder, true, true>(lds, g, S, E, tid);
#endif
 }
        GRID_BAR();
        {
            IDS(); GAS unsigned char* ws = FRESH_WS(); KP kp = FRESH_P(); (void)kp; const GAS bf16_t* wl = Wc + (size_t)l * LAYER_W;
            for (int i = gtid; i < MTOK; i += NT) rowssB[i] = 0ull;
            pg8::Gemm g{XB, wl + OFF_UP, MTOK, FF, DM, DM}; pg8::StaticOrder S; S.init(MTOK, FF, G, bx);
            pg8::EpiUp E{ws, (int)WS_ROWSSA};

#ifndef NO_G4
pg8::gemm_phase<pg8::EpiUp, pg8::StaticOrder, true, true>(lds, g, S, E, tid);
#endif

        }
        GRID_BAR();
        { IDS(); GAS unsigned char* ws = FRESH_WS(); KP kp = FRESH_P(); (void)kp; const GAS bf16_t* wl = Wc + (size_t)l * LAYER_W;
          pg8::Gemm g{U, wl + OFF_DN, MTOK, DM, FF, FF}; pg8::StaticOrder S; S.init(MTOK, DM, G, bx);
          pg8::EpiRes E{ws, (int)WS_ROWSSB};

#ifndef NO_G3
pg8::gemm_phase<pg8::EpiRes, pg8::StaticOrder, true, true>(lds, g, S, E, tid);
#endif
 }
        GRID_BAR();
    }
    { IDS(); GAS unsigned char* ws = FRESH_WS(); KP kp = FRESH_P(); (void)kp;
    for (int m = gw; m < MTOK; m += NGW) {
        GAS f32x4* orow = (GAS f32x4*)(((GAS float*)kp->out) + (size_t)m * DM);
        const GAS u32x4* xrow = (const GAS u32x4*)(XB + (size_t)m * DM);
        const float rs = pg8::rs_from(rowssB[m]);
#pragma unroll
        for (int j = 0; j < 2; ++j) {
            const u32x4 p = xrow[lane + 64 * j];
            const f32x4 g0 = *((const GAS f32x4*)((const GAS float*)kp->nfinal) + 2 * (lane + 64 * j)), g1 = *((const GAS f32x4*)((const GAS float*)kp->nfinal) + 2 * (lane + 64 * j) + 1);
            f32x4 a, c;
            a[0] = __uint_as_float(p.x << 16); a[1] = __uint_as_float(p.x & 0xffff0000u); a[2] = __uint_as_float(p.y << 16); a[3] = __uint_as_float(p.y & 0xffff0000u);
            c[0] = __uint_as_float(p.z << 16); c[1] = __uint_as_float(p.z & 0xffff0000u); c[2] = __uint_as_float(p.w << 16); c[3] = __uint_as_float(p.w & 0xffff0000u);
            orow[2 * (lane + 64 * j)] = a * rs * g0; orow[2 * (lane + 64 * j) + 1] = c * rs * g1;
        }
    } }
}

extern "C" void kernel_launch(void* const* d_in, const int* in_sizes, int n_in, void* d_out, int out_size, void* d_ws, size_t ws_size, hipStream_t stream) {
    static int grid_blocks = 0;
    if (grid_blocks == 0) {
        if (n_in != 12 || in_sizes[0] != MTOK * DM || out_size != MTOK * DM || ws_size < WS_END) {
            fprintf(stderr, "kernel_launch: unexpected shapes: n_in %d in0 %d out %d ws %zu (need %zu)\n", n_in, n_in > 0 ? in_sizes[0] : -1, out_size, ws_size, (size_t)WS_END); grid_blocks = -1; return; }
        int dev = 0, cus = 0, per_cu = 0;
        hipGetDevice(&dev);
        hipDeviceGetAttribute(&cus, hipDeviceAttributeMultiprocessorCount, dev);
        if (hipFuncSetAttribute((const void*)fwd_megakernel, hipFuncAttributeMaxDynamicSharedMemorySize, LDS_BYTES) != hipSuccess) { fprintf(stderr, "kernel_launch: hipFuncSetAttribute failed\n"); grid_blocks = -1; return; }
        if (hipOccupancyMaxActiveBlocksPerMultiprocessor(&per_cu, (const void*)fwd_megakernel, NTHREADS, LDS_BYTES) != hipSuccess || per_cu < 1) { fprintf(stderr, "kernel_launch: occupancy query failed (%d)\n", per_cu); (void)hipGetLastError(); per_cu = 1; }
        grid_blocks = cus * per_cu;
        fprintf(stderr, "kernel_launch: cus %d per_cu %d grid %d\n", cus, per_cu, grid_blocks);
    }
    if (grid_blocks < 0) return;
    Params p{};
    p.x = (const float*)d_in[0]; p.w_in = (const float*)d_in[1]; p.w_out = (const float*)d_in[2]; p.rpb = (const float*)d_in[3];
    p.dfw = (const float*)d_in[4]; p.dbw = (const float*)d_in[5]; p.rgain = (const float*)d_in[6]; p.nmix = (const float*)d_in[7]; p.nmlp = (const float*)d_in[8];
    p.w_up = (const float*)d_in[9]; p.w_down = (const float*)d_in[10]; p.nfinal = (const float*)d_in[11];
    p.out = (float*)d_out; p.ws = (unsigned char*)d_ws;
    p.inv2pi0 = 1.0 / (2.0 * 3.14159265358979323846); p.rbase = std::pow(10000.0, -1.0 / 32.0);
    if (hipMemsetAsync((char*)d_ws + WS_BAR, 0, BAR_ZERO_BYTES, stream) != hipSuccess) { fprintf(stderr, "kernel_launch: memset failed\n"); return; }
    void* args[] = {&p};
    hipError_t e = hipLaunchCooperativeKernel((const void*)fwd_megakernel, dim3(grid_blocks), dim3(NTHREADS), args, LDS_BYTES, stream);
    if (e != hipSuccess) fprintf(stderr, "cooperative launch failed: %s (grid %d)\n", hipGetErrorString(e), grid_blocks);
}
```
